# Optimizing an MI355X kernel written in HIP

```python
import math
import jax, jax.numpy as jnp
from jax import lax
import numpy as np

D_MODEL = 2048
BATCH = 2
SEQ = 4096
DEPTH = 1

GRID_W = 64
CTX_LEN = 256
GLA_HEADS = 8
GLA_DK = 64
GLA_DV = 128
GLA_RANK = 16
GLA_TAU = 16.0
GLA_CHUNK = 64
DIFF_HEADS = 8
DIFF_DQK = 64
DIFF_DV = 128
D_FF = 5632
CONV_W = 3
Q_BLOCK = 128
ROPE_THETA = 10000.0
EPS = 1e-6

GLA_QK = GLA_HEADS * GLA_DK
GLA_V = GLA_HEADS * GLA_DV
DIFF_QK = DIFF_HEADS * 2 * DIFF_DQK
DIFF_V = DIFF_HEADS * DIFF_DV
IN_SIZES = [GLA_QK, GLA_QK, GLA_V, GLA_V, GLA_RANK, GLA_RANK, DIFF_QK, DIFF_QK, DIFF_V]
D_IN = sum(IN_SIZES)
IN_OFFSETS = [int(v) for v in np.cumsum(IN_SIZES)[:-1]]

kernel_name = "hybrid_gla_diffattn_convffn_dit_block"


def rms_norm(x, w):
    xf = x.astype(jnp.float32)
    y = xf * lax.rsqrt(jnp.mean(xf * xf, axis=-1, keepdims=True) + EPS)
    return (y * w.astype(jnp.float32)).astype(x.dtype)


def modulate(h, shift, scale):
    return h * (1.0 + scale) + shift


def to_heads(t, n, d):
    B, T, _ = t.shape
    return t.reshape(B, T, n, d).transpose(0, 2, 1, 3)


def from_heads(t):
    B, n, T, d = t.shape
    return t.transpose(0, 2, 1, 3).reshape(B, T, n * d)


def rope_axis(x, ang):
    half = x.shape[-1] // 2
    x1, x2 = x[..., :half], x[..., half:]
    cos = jnp.cos(ang).astype(x.dtype)
    sin = jnp.sin(ang).astype(x.dtype)
    return jnp.concatenate([x1 * cos - x2 * sin, x2 * cos + x1 * sin], axis=-1)


def rope_2d(x, ang_row, ang_col):
    r = x.shape[-1] // 2
    return jnp.concatenate([rope_axis(x[..., :r], ang_row), rope_axis(x[..., r:], ang_col)], axis=-1)


def gla_scan(q, k, v, log_a, s0):
    B, H, T, dk = q.shape
    dv = v.shape[-1]
    n = T // GLA_CHUNK

    def chunks(t):
        return jnp.moveaxis(t.astype(jnp.float32).reshape(B, H, n, GLA_CHUNK, t.shape[-1]), 2, 0)

    lower = jnp.tril(jnp.ones((GLA_CHUNK, GLA_CHUNK), dtype=bool))[:, :, None]

    def step(state, inp):
        qc, kc, vc, ac = inp
        b = jnp.cumsum(ac, axis=2)
        o_inter = jnp.einsum('bhid,bhde->bhie', qc * jnp.exp(b), state)
        rel = b[:, :, :, None, :] - b[:, :, None, :, :]
        decay = jnp.exp(jnp.where(lower, rel, -jnp.inf))
        scores = jnp.einsum('bhid,bhjd,bhijd->bhij', qc, kc, decay)
        o_intra = jnp.einsum('bhij,bhje->bhie', scores, vc)
        b_last = b[:, :, -1:, :]
        state = jnp.exp(b_last[:, :, 0, :])[..., None] * state + jnp.einsum(
            'bhjd,bhje->bhde', kc * jnp.exp(b_last - b), vc)
        return state, o_inter + o_intra

    s_final, o = lax.scan(step, s0.astype(jnp.float32), (chunks(q), chunks(k), chunks(v), chunks(log_a)))
    o = jnp.moveaxis(o, 0, 2).reshape(B, H, T, dv)
    return o.astype(v.dtype), s_final


def diff_softmax(q, k, v, lam):
    s = jnp.einsum('bhmqd,bhmkd->bhmqk', q, k).astype(jnp.float32) * (DIFF_DQK ** -0.5)
    p = jax.nn.softmax(s, axis=-1)
    a = p[:, :, 0] - lam * p[:, :, 1]
    return jnp.einsum('bhqk,bhkd->bhqd', a.astype(v.dtype), v)


def conv_ffn(h, w_up, conv_w, conv_b, w_down):
    u = h @ w_up
    T = u.shape[1]
    pad = CONV_W // 2
    up = jnp.pad(u, ((0, 0), (pad, pad), (0, 0)))
    u = sum(up[:, j:j + T] * conv_w[j] for j in range(CONV_W)) + conv_b
    gate, val = jnp.split(u, 2, axis=-1)
    return (jax.nn.silu(gate) * val) @ w_down


def hybrid_layer(x, ctx, c, c_ctx, w_ada, b_ada, norm1_w, w_in, w_a_up_f, b_a_f, w_a_up_b, b_a_b,
                 gla_onorm_w, diff_qnorm_w, diff_knorm_w, lambda_q1, lambda_k1, lambda_q2, lambda_k2,
                 diff_onorm_w, w_proj_gla, w_proj_diff, w_gate, b_gate, w_out, norm2_w, w_up, conv_w,
                 conv_b, w_down, ang_row, ang_col, lam_init, update_ctx):
    B, S, _ = x.shape
    sh1, sc1, g1, sh2, sc2, g2 = [m[:, None, :] for m in
                                  jnp.split(jax.nn.silu(c) @ w_ada + b_ada, 6, axis=-1)]
    sh1c, sc1c, g1c, sh2c, sc2c, g2c = jnp.split(jax.nn.silu(c_ctx) @ w_ada + b_ada, 6, axis=-1)

    h_l = modulate(rms_norm(x, norm1_w), sh1, sc1)
    h_c = modulate(rms_norm(ctx, norm1_w), sh1c, sc1c)
    gq_l, gk_l, gv_l, gr_l, gaf_l, gab_l, dq_l, dk_l, dv_l = jnp.split(h_l @ w_in, IN_OFFSETS, axis=-1)
    gq_c, gk_c, gv_c, gr_c, gaf_c, gab_c, dq_c, dk_c, dv_c = jnp.split(h_c @ w_in, IN_OFFSETS, axis=-1)

    def gla_heads(gq, gk, gv, gaf, gab):
        q = to_heads(gq, GLA_HEADS, GLA_DK) * (GLA_DK ** -0.5)
        k = to_heads(gk, GLA_HEADS, GLA_DK)
        v = to_heads(gv, GLA_HEADS, GLA_DV)
        la_f = to_heads(jax.nn.log_sigmoid((gaf @ w_a_up_f + b_a_f).astype(jnp.float32)) / GLA_TAU,
                        GLA_HEADS, GLA_DK)
        la_b = to_heads(jax.nn.log_sigmoid((gab @ w_a_up_b + b_a_b).astype(jnp.float32)) / GLA_TAU,
                        GLA_HEADS, GLA_DK)
        return q, k, v, la_f, la_b

    aq_l, ak_l, av_l, alf_l, alb_l = gla_heads(gq_l, gk_l, gv_l, gaf_l, gab_l)
    aq_c, ak_c, av_c, alf_c, alb_c = gla_heads(gq_c, gk_c, gv_c, gaf_c, gab_c)
    zeros = jnp.zeros((B, GLA_HEADS, GLA_DK, GLA_DV), jnp.float32)

    def flip(t):
        return jnp.flip(t, axis=2)

    o_cf, s_cf = gla_scan(aq_c, ak_c, av_c, alf_c, zeros)
    o_lf, _ = gla_scan(aq_l, ak_l, av_l, alf_l, s_cf)
    o_cb, s_cb = gla_scan(flip(aq_c), flip(ak_c), flip(av_c), flip(alb_c), zeros)
    o_lb, _ = gla_scan(flip(aq_l), flip(ak_l), flip(av_l), flip(alb_l), s_cb)

    def gla_out(o, r):
        return from_heads(rms_norm(o, gla_onorm_w)) * jax.nn.silu(r)

    def diff_qk(t, w):
        Bt, T, _ = t.shape
        t = t.reshape(Bt, T, DIFF_HEADS, 2, DIFF_DQK).transpose(0, 2, 3, 1, 4)
        return rms_norm(t, w)

    q_l = rope_2d(diff_qk(dq_l, diff_qnorm_w), ang_row, ang_col)
    k_l = rope_2d(diff_qk(dk_l, diff_knorm_w), ang_row, ang_col)
    k_c = diff_qk(dk_c, diff_knorm_w)
    v_l = to_heads(dv_l, DIFF_HEADS, DIFF_DV)
    v_c = to_heads(dv_c, DIFF_HEADS, DIFF_DV)
    lam = (jnp.exp(jnp.sum(lambda_q1.astype(jnp.float32) * lambda_k1.astype(jnp.float32)))
           - jnp.exp(jnp.sum(lambda_q2.astype(jnp.float32) * lambda_k2.astype(jnp.float32))) + lam_init)

    k_all = jnp.concatenate([k_c, k_l], axis=3)
    v_all = jnp.concatenate([v_c, v_l], axis=2)
    nb = S // Q_BLOCK
    q_blocks = jnp.moveaxis(q_l.reshape(B, DIFF_HEADS, 2, nb, Q_BLOCK, DIFF_DQK), 3, 0)
    o_diff = lax.map(lambda qb: diff_softmax(qb, k_all, v_all, lam), q_blocks)
    o_diff = jnp.moveaxis(o_diff, 0, 2).reshape(B, DIFF_HEADS, S, DIFF_DV)

    def diff_out(o):
        return from_heads(rms_norm(o, diff_onorm_w) * (1.0 - lam_init))

    def merge(h, ya, yb):
        g_a, g_b = jnp.split(jax.nn.sigmoid(h @ w_gate + b_gate), 2, axis=-1)
        return (g_a * (ya @ w_proj_gla) + g_b * (yb @ w_proj_diff)) @ w_out

    mix_l = merge(h_l, gla_out(o_lf + flip(o_lb), gr_l), diff_out(o_diff))
    x_new = x + g1 * mix_l
    h2_l = modulate(rms_norm(x_new, norm2_w), sh2, sc2)
    x_new = x_new + g2 * conv_ffn(h2_l, w_up, conv_w, conv_b, w_down)

    if update_ctx:
        q_c = diff_qk(dq_c, diff_qnorm_w)
        o_diff_c = diff_softmax(q_c, k_c, v_c, lam)
        mix_c = merge(h_c, gla_out(o_cf + flip(o_cb), gr_c), diff_out(o_diff_c))
        ctx = ctx + g1c * mix_c
        h2_c = modulate(rms_norm(ctx, norm2_w), sh2c, sc2c)
        ctx = ctx + g2c * conv_ffn(h2_c, w_up, conv_w, conv_b, w_down)
    return x_new, ctx


def setup_inputs(seed: int = 0) -> dict:
    key = jax.random.key(seed)
    ks = jax.random.split(key, 32)
    f32 = jnp.float32
    D = D_MODEL

    def nrm(k, shape, scale):
        return jax.random.normal(k, shape, f32) * scale

    def gain(k, shape):
        return 1.0 + 0.02 * jax.random.normal(k, shape, f32)

    return {
        "x": nrm(ks[0], (BATCH, SEQ, D), 1.0),
        "c": nrm(ks[1], (BATCH, D), 1.0),
        "ctx": nrm(ks[2], (BATCH, CTX_LEN, D), 1.0),
        "c_ctx": nrm(ks[3], (D,), 1.0),
        "w_ada": nrm(ks[4], (DEPTH, D, 6 * D), D ** -0.5),
        "b_ada": nrm(ks[5], (DEPTH, 6 * D), 0.01),
        "norm1_w": gain(ks[6], (DEPTH, D)),
        "w_in": nrm(ks[7], (DEPTH, D, D_IN), D ** -0.5),
        "w_a_up_f": nrm(ks[8], (DEPTH, GLA_RANK, GLA_QK), GLA_RANK ** -0.5),
        "b_a_f": 1.0 + nrm(ks[9], (DEPTH, GLA_QK), 0.1),
        "w_a_up_b": nrm(ks[10], (DEPTH, GLA_RANK, GLA_QK), GLA_RANK ** -0.5),
        "b_a_b": 1.0 + nrm(ks[11], (DEPTH, GLA_QK), 0.1),
        "gla_onorm_w": gain(ks[12], (DEPTH, GLA_DV)),
        "diff_qnorm_w": gain(ks[13], (DEPTH, DIFF_DQK)),
        "diff_knorm_w": gain(ks[14], (DEPTH, DIFF_DQK)),
        "lambda_q1": nrm(ks[15], (DEPTH, DIFF_DQK), 0.1),
        "lambda_k1": nrm(ks[16], (DEPTH, DIFF_DQK), 0.1),
        "lambda_q2": nrm(ks[17], (DEPTH, DIFF_DQK), 0.1),
        "lambda_k2": nrm(ks[18], (DEPTH, DIFF_DQK), 0.1),
        "diff_onorm_w": gain(ks[19], (DEPTH, DIFF_DV)),
        "w_proj_gla": nrm(ks[20], (DEPTH, GLA_V, D), GLA_V ** -0.5),
        "w_proj_diff": nrm(ks[21], (DEPTH, DIFF_V, D), DIFF_V ** -0.5),
        "w_gate": nrm(ks[22], (DEPTH, D, 2 * D), D ** -0.5),
        "b_gate": nrm(ks[23], (DEPTH, 2 * D), 0.01),
        "w_out": nrm(ks[24], (DEPTH, D, D), D ** -0.5),
        "norm2_w": gain(ks[25], (DEPTH, D)),
        "w_up": nrm(ks[26], (DEPTH, D, 2 * D_FF), D ** -0.5),
        "conv_w": nrm(ks[27], (DEPTH, CONV_W, 2 * D_FF), CONV_W ** -0.5),
        "conv_b": nrm(ks[28], (DEPTH, 2 * D_FF), 0.01),
        "w_down": nrm(ks[29], (DEPTH, D_FF, D), D_FF ** -0.5),
    }


def reference(x, c, ctx, c_ctx, w_ada, b_ada, norm1_w, w_in, w_a_up_f, b_a_f, w_a_up_b, b_a_b,
              gla_onorm_w, diff_qnorm_w, diff_knorm_w, lambda_q1, lambda_k1, lambda_q2, lambda_k2,
              diff_onorm_w, w_proj_gla, w_proj_diff, w_gate, b_gate, w_out, norm2_w, w_up, conv_w,
              conv_b, w_down):
    S = x.shape[1]
    ROWS = S // GRID_W
    pos_row = jnp.repeat(jnp.arange(ROWS), GRID_W).astype(jnp.float32)
    pos_col = jnp.tile(jnp.arange(GRID_W), ROWS).astype(jnp.float32)
    n_freq = DIFF_DQK // 4
    inv_freq = ROPE_THETA ** (-jnp.arange(n_freq, dtype=jnp.float32) / n_freq)
    ang_row = pos_row[:, None] * inv_freq
    ang_col = pos_col[:, None] * inv_freq
    for i in range(DEPTH):
        lam_init = 0.8 - 0.6 * math.exp(-0.3 * i)
        x, ctx = hybrid_layer(
            x, ctx, c, c_ctx, w_ada[i], b_ada[i], norm1_w[i], w_in[i], w_a_up_f[i], b_a_f[i],
            w_a_up_b[i], b_a_b[i], gla_onorm_w[i], diff_qnorm_w[i], diff_knorm_w[i], lambda_q1[i],
            lambda_k1[i], lambda_q2[i], lambda_k2[i], diff_onorm_w[i], w_proj_gla[i], w_proj_diff[i],
            w_gate[i], b_gate[i], w_out[i], norm2_w[i], w_up[i], conv_w[i], conv_b[i], w_down[i],
            ang_row, ang_col, lam_init, i < DEPTH - 1)
    return x
```

```cpp
#include <hip/hip_runtime.h>
#include <hip/hip_cooperative_groups.h>
#include <cstdio>
#include <cstdint>
namespace cg = cooperative_groups;
namespace pg8 {
#define PG8_LAS __attribute__((address_space(3)))
typedef unsigned short bf16_t;
typedef short bf16x8 __attribute__((ext_vector_type(8)));
typedef float f32x4 __attribute__((ext_vector_type(4)));
typedef unsigned u32x4 __attribute__((ext_vector_type(4)));
constexpr int BM = 256, BK = 64, HALF = 128, HTB = HALF * BK * 2  , STAGE_BYTES = 8 * HTB, NXCD = 8, WGM = 8;

__host__ __device__ __forceinline__ int lds_byte(int r, int c) { const int st = (r >> 4) * 2 + (c >> 5), rr = r & 15, cc = c & 31, ob = rr * 64 + cc * 2; return st * 1024 + (ob ^ (((ob >> 9) & 1) << 5)); }
__host__ __device__ __forceinline__ void stage_rc(int b, int& R, int& C) { const int st = b / 1024, sb = b % 1024, swz = sb ^ (((sb >> 9) & 1) << 5); R = (st >> 1) * 16 + swz / 64; C = (st & 1) * 32 + (swz % 64) / 2; }
__host__ __device__ __forceinline__ int perm32(int rho) { const int n = rho >> 4, i = rho & 15; return 8 * (i >> 2) + 4 * n + (i & 3); }

struct Unit { int pm, pn; };
struct Gemm { const bf16_t* A; const bf16_t* Bt; int M, N, K; };

struct StaticOrder {
    int nM, nN, nwg, G, c, conv;
    __host__ __device__ void init(int M, int N, int G_, int c_) { nM = M / BM; nN = N / BM; nwg = nM * nN; G = G_; c = c_; conv = 0; }
    __host__ __device__ long arow(int pm) const { return conv ? (long)(pm / 17) * 4096 + 254 * (pm % 17) - 1 : (long)pm * BM; }
    __host__ __device__ bool next(int i, Unit& u) const {
        const long L = (long)i * G + c; if (L >= nwg) return false;
        int wgid = (int)L; { const int q = nwg / NXCD, r = nwg % NXCD, xcd = wgid % NXCD, off = wgid / NXCD; wgid = (xcd < r ? xcd * (q + 1) : r * (q + 1) + (xcd - r) * q) + off; }
        const int nig = WGM * nN, gid = wgid / nig, fm = gid * WGM, gsz = (nM - fm) < WGM ? (nM - fm) : WGM;
        u.pm = fm + ((wgid % nig) % gsz); u.pn = (wgid % nig) / gsz; return true;
    }
    __device__ __forceinline__ void a_ready(const Unit&) const {}
    __device__ __forceinline__ void done(const Unit&) const {}
};

typedef float f32x2c_t __attribute__((ext_vector_type(2))); typedef __bf16 bf16x2c_t __attribute__((ext_vector_type(2)));
__device__ __forceinline__ unsigned cvt_pk_bf16(float lo, float hi) { f32x2c_t v = {lo, hi}; bf16x2c_t b = __builtin_convertvector(v, bf16x2c_t); return __builtin_bit_cast(unsigned, b); }

template <class Epi, class Sched, bool ALIGN_EPI = false, bool SP2 = false>
__device__ __forceinline__ void gemm_phase(PG8_LAS unsigned char* lds, const Gemm g, const Sched& S, const Epi& E) {
    const int tid = threadIdx.x, wid = __builtin_amdgcn_readfirstlane(tid >> 6), lane = tid & 63, wr = wid >> 2, wc = wid & 3, fr = lane & 15, fq = lane >> 4;
    const int K = g.K, nt = K / BK;
    unsigned voffA[2], voffB[2];
#pragma unroll
    for (int i = 0; i < 2; ++i) { int R, C; stage_rc(tid * 16 + i * 8192, R, C); const int Rb = Epi::PERM ? ((R & ~31) + perm32(R & 31)) : R;
        voffA[i] = (unsigned)(R * K + C) * 2u; voffB[i] = (unsigned)(Rb * K + C) * 2u; }
    const size_t kstep = (size_t)(BK * 2);
    const size_t hstep = (size_t)HALF * K * 2;
    const size_t tstep = 2 * hstep;
    const unsigned ldsw = (unsigned)wid * 1024u;
    const int aoff = lds_byte(wr * 64 + fr, fq * 8), boff = lds_byte(wc * 32 + fr, fq * 8);
#define PG8_SA(b, h) (((b) * 2 + (h)) * HTB)
#define PG8_SB(b, h) ((4 + (b) * 2 + (h)) * HTB)
#define PG8_STAGE(bufoff, gbase, voff) do { _Pragma("unroll") for (int _i = 0; _i < 2; ++_i) \
        __builtin_amdgcn_global_load_lds((const unsigned*)((const char*)(gbase) + (voff)[_i]), (PG8_LAS unsigned*)(lds + (bufoff) + ldsw + _i * 8192), 16, 0, 0); } while (0)
#define PG8_LDA(dst, b, h) do { _Pragma("unroll") for (int m = 0; m < 4; ++m) _Pragma("unroll") for (int k = 0; k < 2; ++k) dst[m][k] = *(const PG8_LAS bf16x8*)(lds + PG8_SA(b, h) + aoff + m * 2048 + k * 1024); } while (0)
#define PG8_LDB(dst, b, h) do { _Pragma("unroll") for (int n = 0; n < 2; ++n) _Pragma("unroll") for (int k = 0; k < 2; ++k) dst[n][k] = *(const PG8_LAS bf16x8*)(lds + PG8_SB(b, h) + boff + n * 2048 + k * 1024); } while (0)
#define PG8_MMA(ai, bj, At, Bt) do { __builtin_amdgcn_s_setprio(1); _Pragma("unroll") for (int m = 0; m < 4; ++m) _Pragma("unroll") for (int n = 0; n < 2; ++n) _Pragma("unroll") for (int k = 0; k < 2; ++k) \
        acc[ai][bj][m][n] = __builtin_amdgcn_mfma_f32_16x16x32_bf16(Bt[n][k], At[m][k], acc[ai][bj][m][n], 0, 0, 0); __builtin_amdgcn_s_setprio(0); } while (0)
#define PG8_WAIT_V(n) asm volatile("s_waitcnt vmcnt(" #n ")" ::: "memory")
#define PG8_WAIT_L(n) asm volatile("s_waitcnt lgkmcnt(" #n ")" ::: "memory")
#define PG8_BAR __builtin_amdgcn_s_barrier()
#define PG8_SCHED __builtin_amdgcn_sched_barrier(0)
    Unit cur, nxt; int ui = 0;
    if (!S.next(0, cur)) return;
    f32x4 acc[2][2][4][2];
#pragma unroll
    for (int a = 0; a < 2; ++a)
#pragma unroll
        for (int b = 0; b < 2; ++b)
#pragma unroll
            for (int m = 0; m < 4; ++m)
#pragma unroll
                for (int n = 0; n < 2; ++n) acc[a][b][m][n] = (f32x4){0.f, 0.f, 0.f, 0.f};
    bf16x8 At[4][2], B0[2][2], B1[2][2];
    const char* cA = (const char*)g.A + S.arow(cur.pm) * (long)K * 2; const char* cB = (const char*)g.Bt + (size_t)cur.pn * tstep;
    S.a_ready(cur);
    if constexpr (SP2) {
        PG8_STAGE(PG8_SB(0, 0), cB, voffB); PG8_STAGE(PG8_SB(0, 1), cB + hstep, voffB); PG8_STAGE(PG8_SA(0, 0), cA, voffA); PG8_STAGE(PG8_SA(0, 1), cA + hstep, voffA);
        if (wr == 1) PG8_BAR;
        PG8_WAIT_V(2); PG8_BAR;
        PG8_STAGE(PG8_SB(1, 0), cB + kstep, voffB); PG8_STAGE(PG8_SA(1, 0), cA + kstep, voffA); PG8_STAGE(PG8_SB(1, 1), cB + hstep + kstep, voffB);
        PG8_WAIT_V(6); PG8_BAR;
    } else {
        PG8_STAGE(PG8_SB(0, 0), cB, voffB); PG8_STAGE(PG8_SA(0, 0), cA, voffA); PG8_STAGE(PG8_SB(0, 1), cB + hstep, voffB); PG8_STAGE(PG8_SA(0, 1), cA + hstep, voffA);
        if (wr == 1) PG8_BAR;
        PG8_WAIT_V(4); PG8_BAR;
        PG8_STAGE(PG8_SB(1, 0), cB + kstep, voffB); PG8_STAGE(PG8_SA(1, 0), cA + kstep, voffA); PG8_STAGE(PG8_SB(1, 1), cB + hstep + kstep, voffB);
        PG8_WAIT_V(6); PG8_BAR;
    }
    for (;;) {
        const bool has_next = S.next(ui + 1, nxt);
        const char* nA = has_next ? (const char*)g.A + S.arow(nxt.pm) * (long)K * 2 : cA; const char* nB = has_next ? (const char*)g.Bt + (size_t)nxt.pn * tstep : cB;
        for (int t = 0; t < nt; t += 2) {
            if constexpr (Epi::MIDK > 0) { if (t == Epi::MIDK) E.mid(acc, cur, wr, wc, fr, fq); }
            const bool last = (t == nt - 2);
            const char* a1 = cA + (size_t)(t + 1) * kstep;
            const char* a2 = last ? nA : cA + (size_t)(t + 2) * kstep; const char* b2 = last ? nB : cB + (size_t)(t + 2) * kstep;
            const char* a3 = a2 + kstep; const char* b3 = b2 + kstep;
            if (last && has_next) S.a_ready(nxt);
            if constexpr (SP2) {
            PG8_LDB(B0, 0, 0); PG8_LDB(B1, 0, 1); PG8_SCHED; PG8_LDA(At, 0, 0); PG8_STAGE(PG8_SA(1, 1), a1 + hstep, voffA);
            PG8_WAIT_V(8); PG8_WAIT_L(0); PG8_BAR; PG8_MMA(0, 0, At, B0); PG8_MMA(0, 1, At, B1); PG8_BAR; PG8_SCHED;
            PG8_LDA(At, 0, 1); PG8_STAGE(PG8_SB(0, 0), b2, voffB); PG8_STAGE(PG8_SB(0, 1), b2 + hstep, voffB); PG8_STAGE(PG8_SA(0, 0), a2, voffA);
            PG8_WAIT_V(8); PG8_WAIT_L(0); PG8_BAR; PG8_MMA(1, 0, At, B0); PG8_MMA(1, 1, At, B1); PG8_BAR; PG8_SCHED;
            PG8_LDB(B0, 1, 0); PG8_LDB(B1, 1, 1); PG8_SCHED; PG8_LDA(At, 1, 0); PG8_STAGE(PG8_SA(0, 1), a2 + hstep, voffA);
            PG8_WAIT_V(8); PG8_WAIT_L(0); PG8_BAR; PG8_MMA(0, 0, At, B0); PG8_MMA(0, 1, At, B1); PG8_BAR; PG8_SCHED;
            PG8_LDA(At, 1, 1); PG8_STAGE(PG8_SB(1, 0), b3, voffB); PG8_STAGE(PG8_SB(1, 1), b3 + hstep, voffB); PG8_STAGE(PG8_SA(1, 0), a3, voffA);
            PG8_WAIT_V(8); PG8_WAIT_L(0); PG8_BAR; PG8_MMA(1, 0, At, B0); PG8_MMA(1, 1, At, B1); PG8_BAR; PG8_SCHED;
            } else {
            PG8_LDB(B0, 0, 0); PG8_SCHED; PG8_LDA(At, 0, 0); PG8_STAGE(PG8_SA(1, 1), a1 + hstep, voffA);
            PG8_WAIT_L(8); PG8_BAR; PG8_WAIT_L(0); PG8_MMA(0, 0, At, B0); PG8_BAR; PG8_SCHED;
            PG8_LDB(B1, 0, 1); PG8_STAGE(PG8_SB(0, 0), b2, voffB);
            PG8_BAR; PG8_WAIT_L(0); PG8_MMA(0, 1, At, B1); PG8_BAR;
            PG8_LDA(At, 0, 1); PG8_STAGE(PG8_SA(0, 0), a2, voffA);
            PG8_BAR; PG8_WAIT_L(0); PG8_MMA(1, 0, At, B0); PG8_BAR; PG8_SCHED;
            PG8_STAGE(PG8_SB(0, 1), b2 + hstep, voffB);
            PG8_WAIT_V(6); PG8_BAR; PG8_MMA(1, 1, At, B1); PG8_BAR;
            PG8_LDB(B0, 1, 0); PG8_SCHED; PG8_LDA(At, 1, 0); PG8_STAGE(PG8_SA(0, 1), a2 + hstep, voffA);
            PG8_WAIT_L(8); PG8_BAR; PG8_WAIT_L(0); PG8_MMA(0, 0, At, B0); PG8_BAR; PG8_SCHED;
            PG8_LDB(B1, 1, 1); PG8_STAGE(PG8_SB(1, 0), b3, voffB);
            PG8_BAR; PG8_WAIT_L(0); PG8_MMA(0, 1, At, B1); PG8_BAR;
            PG8_LDA(At, 1, 1); PG8_STAGE(PG8_SA(1, 0), a3, voffA);
            PG8_BAR; PG8_WAIT_L(0); PG8_MMA(1, 0, At, B0); PG8_BAR; PG8_SCHED;
            PG8_STAGE(PG8_SB(1, 1), b3 + hstep, voffB);
            PG8_WAIT_V(6); PG8_BAR; PG8_MMA(1, 1, At, B1); PG8_BAR;
            }
        }
        if constexpr (ALIGN_EPI) { if (wr == 0) PG8_BAR; }
        if constexpr (!Epi::AFTER_DRAIN) { E(acc, cur, wr, wc, fr, fq); S.done(cur); }
        if (!has_next) break;
#pragma unroll
        for (int a = 0; a < 2; ++a)
#pragma unroll
            for (int b = 0; b < 2; ++b)
#pragma unroll
                for (int m = 0; m < 4; ++m)
#pragma unroll
                    for (int n = 0; n < 2; ++n) acc[a][b][m][n] = (f32x4){0.f, 0.f, 0.f, 0.f};
        cur = nxt; cA = nA; cB = nB; ++ui;
        if constexpr (ALIGN_EPI) { if (wr == 1) PG8_BAR; }
    }
    PG8_WAIT_V(0);
    if constexpr (!ALIGN_EPI) { if (wr == 0) PG8_BAR; }
    PG8_BAR;
    if constexpr (Epi::AFTER_DRAIN) { E.fused(acc, cur, wr, wc, fr, fq, lds, wid, lane); S.done(cur); }
#undef PG8_SA
#undef PG8_SB
#undef PG8_STAGE
#undef PG8_LDA
#undef PG8_LDB
#undef PG8_MMA
#undef PG8_WAIT_V
#undef PG8_WAIT_L
#undef PG8_BAR
#undef PG8_SCHED
}
}

#define GAS __attribute__((address_space(1)))
#define LAS __attribute__((address_space(3)))
typedef unsigned short bf16;
typedef unsigned v4u __attribute__((ext_vector_type(4)));
typedef unsigned v2u __attribute__((ext_vector_type(2)));
typedef float f32x4 __attribute__((ext_vector_type(4)));
typedef float f32x16 __attribute__((ext_vector_type(16)));
typedef short bf16x8 __attribute__((ext_vector_type(8)));
typedef short s16x4 __attribute__((ext_vector_type(4)));
typedef short v4i16_t __attribute__((ext_vector_type(4)));
#define LDS_WAIT() asm volatile("s_waitcnt lgkmcnt(0)" ::: "memory")
#define MFMA16(a, b, c) __builtin_amdgcn_mfma_f32_16x16x32_bf16((a), (b), (c), 0, 0, 0)
#define MFMA32(a, b, c) __builtin_amdgcn_mfma_f32_32x32x16_bf16((a), (b), (c), 0, 0, 0)

typedef float f32x2_t __attribute__((ext_vector_type(2))); typedef __bf16 bf16x2_t __attribute__((ext_vector_type(2)));
__device__ __forceinline__ unsigned pk2(float lo, float hi) { f32x2_t v = {lo, hi}; bf16x2_t b = __builtin_convertvector(v, bf16x2_t); return __builtin_bit_cast(unsigned, b); }
__device__ __forceinline__ unsigned f2bf(float f) { return pk2(f, f) & 0xffffu; }
__device__ __forceinline__ float bf2f(unsigned short h) { return __builtin_bit_cast(float, (unsigned)h << 16); }
__device__ __forceinline__ float bflo(unsigned u) { return __builtin_bit_cast(float, u << 16); }
__device__ __forceinline__ float bfhi(unsigned u) { return __builtin_bit_cast(float, u & 0xffff0000u); }
__device__ __forceinline__ float wave_sum(float v) {
#pragma unroll
    for (int o = 1; o < 64; o <<= 1) v += __shfl_xor(v, o);
    return v;
}
__device__ __forceinline__ float sigmoidf_(float x) { return __builtin_amdgcn_rcpf(1.f + __expf(-x)); }
__device__ __forceinline__ float siluf_(float x) { return x * __builtin_amdgcn_rcpf(1.f + __expf(-x)); }
__device__ __forceinline__ float logsigf_(float z) { return fminf(z, 0.f) - __logf(1.f + __expf(-fabsf(z))); }
__device__ __forceinline__ int crow(int r, int hi) { return (r & 3) + 8 * (r >> 2) + 4 * hi; }

constexpr int DM = 2048, NB = 2, SEQ = 4096, CTXL = 256;
constexpr int ML = NB * SEQ, MC = NB * CTXL, MT = ML + MC;
constexpr int NCAT = 10496, NACT = 6144, DFF = 5632, NUP = 11264, DIN = 6176;
constexpr int NITEM1 = 2 * 8 * 2 * 68;
constexpr float EPS = 1e-6f;
constexpr float LAM_INIT = 0.2f;
constexpr int NW = 8, NT = 512;
constexpr int LDS_BYTES = 147456;

constexpr size_t MiB = 1u << 20;
constexpr size_t WS_LAM = 4096, WS_BAR = 8192, WS_MOD = 65536;
constexpr size_t WS_WPG = 277 * MiB, WS_WPD = 281 * MiB, WS_WO = 395 * MiB, WS_WDN = 1 * MiB;
constexpr size_t WS_H = 23 * MiB, WS_WCAT = 57 * MiB, WS_LR = 98 * MiB, WS_GDEC = 100 * MiB;
constexpr size_t WS_U = 23 * MiB, WS_T1 = 23 * MiB, WS_H2 = 23 * MiB, WS_WUP = 351 * MiB, WS_ACT2 = 111 * MiB;
constexpr size_t WS_ACT1 = 111 * MiB, WS_G = 213 * MiB, WS_U2 = 111 * MiB;
constexpr size_t WS_S = 287 * MiB, WS_MRG = 287 * MiB, WS_YA = 319 * MiB, WS_YB = 335 * MiB, WS_END = 403 * MiB;

struct Args { const float* in[30]; float* out; unsigned char* ws; int ph_lo, ph_hi; };

namespace epi {
using pg8::Unit; using pg8::f32x4; using pg8::u32x4; using pg8::cvt_pk_bf16; using pg8::BM; using pg8::HALF;
#define EPI_LOOP for (int ai = 0; ai < 2; ++ai) for (int m = 0; m < 4; ++m) for (int bj = 0; bj < 2; ++bj)

struct EpiP2 {
    static constexpr bool PERM = true, AFTER_DRAIN = false; static constexpr int MIDK = 0;
    bf16* ACT1; bf16* G; float* LR; const float* b_gate;
    __device__ __forceinline__ void operator()(const f32x4 (&acc)[2][2][4][2], const Unit& u, int wr, int wc, int fr, int fq) const {
        const int row0 = u.pm * BM + wr * 64 + fr, cin = wc * 32 + 8 * fq;
        if (u.pn < 24) {
            const float sc = (u.pn < 2) ? 0.125f : 1.0f;
#pragma unroll
            EPI_LOOP { const f32x4 v0 = acc[ai][bj][m][0] * sc, v1 = acc[ai][bj][m][1] * sc;
                u32x4 w; w.x = cvt_pk_bf16(v0[0], v0[1]); w.y = cvt_pk_bf16(v0[2], v0[3]); w.z = cvt_pk_bf16(v1[0], v1[1]); w.w = cvt_pk_bf16(v1[2], v1[3]);
                *(u32x4*)(ACT1 + (size_t)(row0 + ai * HALF + m * 16) * NACT + u.pn * BM + bj * HALF + cin) = w; }
        } else if (u.pn < 40) {
            if (u.pm < ML / BM) {
                const int ch = (u.pn - 24) * 128 + cin;
                const f32x4 ba0 = *(const f32x4*)(b_gate + ch), ba1 = *(const f32x4*)(b_gate + ch + 4), bb0 = *(const f32x4*)(b_gate + 2048 + ch), bb1 = *(const f32x4*)(b_gate + 2048 + ch + 4);
#pragma unroll
                for (int ai = 0; ai < 2; ++ai)
#pragma unroll
                    for (int m = 0; m < 4; ++m) {
                        const f32x4 za0 = acc[ai][0][m][0] + ba0, za1 = acc[ai][0][m][1] + ba1, zb0 = acc[ai][1][m][0] + bb0, zb1 = acc[ai][1][m][1] + bb1;
                        float rr[8], gg[8];
#pragma unroll
                        for (int e = 0; e < 8; ++e) { const float za = e < 4 ? za0[e & 3] : za1[e & 3], zb = e < 4 ? zb0[e & 3] : zb1[e & 3];
                            const float da = 1.f + __expf(-za), db = 1.f + __expf(-zb); gg[e] = __builtin_amdgcn_rcpf(db); rr[e] = db * __builtin_amdgcn_rcpf(da); }
                        u32x4 wr_, wg_; wr_.x = cvt_pk_bf16(rr[0], rr[1]); wr_.y = cvt_pk_bf16(rr[2], rr[3]); wr_.z = cvt_pk_bf16(rr[4], rr[5]); wr_.w = cvt_pk_bf16(rr[6], rr[7]);
                        wg_.x = cvt_pk_bf16(gg[0], gg[1]); wg_.y = cvt_pk_bf16(gg[2], gg[3]); wg_.z = cvt_pk_bf16(gg[4], gg[5]); wg_.w = cvt_pk_bf16(gg[6], gg[7]);
                        bf16* gp = G + (size_t)(row0 + ai * HALF + m * 16) * 4096 + ch; *(u32x4*)gp = wr_; *(u32x4*)(gp + 2048) = wg_; }
            }
        } else {
            if (wc == 0) {
#pragma unroll
                for (int ai = 0; ai < 2; ++ai)
#pragma unroll
                    for (int m = 0; m < 4; ++m) { float* p = LR + (size_t)(row0 + ai * HALF + m * 16) * 32 + 8 * fq;
                        *(f32x4*)p = acc[ai][0][m][0]; *(f32x4*)(p + 4) = acc[ai][0][m][1]; }
            }
        }
    }
};
struct EpiMrg2 {
    static constexpr bool PERM = true, AFTER_DRAIN = false; static constexpr int MIDK = 16;
    const bf16* G; bf16* MRG;
    __device__ __forceinline__ void mid(f32x4 (&acc)[2][2][4][2], const Unit& u, int wr, int wc, int fr, int fq) const {
        int row0 = u.pm * BM + wr * 64 + fr, c0 = u.pn * BM + wc * 32 + 8 * fq;
        asm volatile("" : "+v"(row0), "+v"(c0));
#pragma unroll
        EPI_LOOP { const int row = row0 + ai * HALF + m * 16, col = c0 + bj * HALF;
            const u32x4 gr = *(const u32x4*)(G + (size_t)row * 4096 + col);
            f32x4 v0 = acc[ai][bj][m][0], v1 = acc[ai][bj][m][1];
            v0[0] *= bflo(gr.x); v0[1] *= bfhi(gr.x); v0[2] *= bflo(gr.y); v0[3] *= bfhi(gr.y);
            v1[0] *= bflo(gr.z); v1[1] *= bfhi(gr.z); v1[2] *= bflo(gr.w); v1[3] *= bfhi(gr.w);
            acc[ai][bj][m][0] = v0; acc[ai][bj][m][1] = v1; __builtin_amdgcn_sched_barrier(0); }
    }
    __device__ __forceinline__ void operator()(const f32x4 (&acc)[2][2][4][2], const Unit& u, int wr, int wc, int fr, int fq) const {
        const int row0 = u.pm * BM + wr * 64 + fr, c0 = u.pn * BM + wc * 32 + 8 * fq;
#pragma unroll
        EPI_LOOP { const int row = row0 + ai * HALF + m * 16, col = c0 + bj * HALF;
            const u32x4 g = *(const u32x4*)(G + (size_t)row * 4096 + 2048 + col);
            const f32x4 a0 = acc[ai][bj][m][0], a1 = acc[ai][bj][m][1];
            u32x4 w; w.x = cvt_pk_bf16(a0[0] * bflo(g.x), a0[1] * bfhi(g.x)); w.y = cvt_pk_bf16(a0[2] * bflo(g.y), a0[3] * bfhi(g.y));
            w.z = cvt_pk_bf16(a1[0] * bflo(g.z), a1[1] * bfhi(g.z)); w.w = cvt_pk_bf16(a1[2] * bflo(g.w), a1[3] * bfhi(g.w));
            *(u32x4*)(MRG + (size_t)row * DM + col) = w; }
    }
};
struct EpiRes {
    static constexpr bool PERM = true, AFTER_DRAIN = false; static constexpr int MIDK = 0;
    const float* base; float* out; const float* gate;
    __device__ __forceinline__ void operator()(const f32x4 (&acc)[2][2][4][2], const Unit& u, int wr, int wc, int fr, int fq) const {
        const int row0 = u.pm * BM + wr * 64 + fr, c0 = u.pn * BM + wc * 32 + 8 * fq;
        const float* gb = gate + (size_t)((u.pm * BM) / SEQ) * 12288;
#pragma unroll
        EPI_LOOP { const int row = row0 + ai * HALF + m * 16, col = c0 + bj * HALF;
            const f32x4 g0 = *(const f32x4*)(gb + col), g1 = *(const f32x4*)(gb + col + 4);
            const float* bp = base + (size_t)row * DM + col; const f32x4 x0 = *(const f32x4*)bp, x1 = *(const f32x4*)(bp + 4);
            float* p = out + (size_t)row * DM + col; *(f32x4*)p = x0 + g0 * acc[ai][bj][m][0]; *(f32x4*)(p + 4) = x1 + g1 * acc[ai][bj][m][1]; }
    }
};
struct EpiPlain {
    static constexpr bool PERM = true, AFTER_DRAIN = false; static constexpr int MIDK = 0;
    bf16* O; int ldc;
    __device__ __forceinline__ void operator()(const f32x4 (&acc)[2][2][4][2], const Unit& u, int wr, int wc, int fr, int fq) const {
        const int row0 = u.pm * BM + wr * 64 + fr, c0 = u.pn * BM + wc * 32 + 8 * fq;
#pragma unroll
        EPI_LOOP { const f32x4 v0 = acc[ai][bj][m][0], v1 = acc[ai][bj][m][1];
            u32x4 w; w.x = cvt_pk_bf16(v0[0], v0[1]); w.y = cvt_pk_bf16(v0[2], v0[3]); w.z = cvt_pk_bf16(v1[0], v1[1]); w.w = cvt_pk_bf16(v1[2], v1[3]);
            *(u32x4*)(O + (size_t)(row0 + ai * HALF + m * 16) * ldc + c0 + bj * HALF) = w; }
    }
};
struct EpiConv {
    static constexpr bool PERM = true, AFTER_DRAIN = false; static constexpr int MIDK = 0;
    bf16* ACT2; const float* conv_w; const float* conv_b; __attribute__((address_space(3))) unsigned* halo;
    __device__ __forceinline__ void operator()(const f32x4 (&acc)[2][2][4][2], const Unit& u, int wr, int wc, int fr, int fq) const {
        unsigned P[2][4][8];
#pragma unroll
        for (int ai = 0; ai < 2; ++ai)
#pragma unroll
            for (int m = 0; m < 4; ++m)
#pragma unroll
                for (int bj = 0; bj < 2; ++bj) { const f32x4 v0 = acc[ai][bj][m][0], v1 = acc[ai][bj][m][1];
                    P[ai][m][4 * bj + 0] = cvt_pk_bf16(v0[0], v0[1]); P[ai][m][4 * bj + 1] = cvt_pk_bf16(v0[2], v0[3]);
                    P[ai][m][4 * bj + 2] = cvt_pk_bf16(v1[0], v1[1]); P[ai][m][4 * bj + 3] = cvt_pk_bf16(v1[2], v1[3]); }
#pragma unroll
        for (int ai = 0; ai < 2; ++ai) { const int rb = 2 * ai + wr;
            if (fr == 0) { __attribute__((address_space(3))) unsigned* hp = halo + (((rb * 2 + 0) * 4 + wc) * 4 + fq) * 8;
#pragma unroll
                for (int e = 0; e < 8; ++e) hp[e] = P[ai][0][e]; }
            if (fr == 15) { __attribute__((address_space(3))) unsigned* hp = halo + (((rb * 2 + 1) * 4 + wc) * 4 + fq) * 8;
#pragma unroll
                for (int e = 0; e < 8; ++e) hp[e] = P[ai][3][e]; } }
        asm volatile("s_waitcnt lgkmcnt(0)" ::: "memory");
        __builtin_amdgcn_s_barrier();
        asm volatile("" ::: "memory");
        const int c8 = u.pn * 128 + wc * 32 + 8 * fq;
        float wg[3][8], wv[3][8], bg[8], bv[8];
#pragma unroll
        for (int j = 0; j < 3; ++j) { const float* cw = conv_w + (size_t)j * NUP + c8;
            const f32x4 a0 = *(const f32x4*)cw, a1 = *(const f32x4*)(cw + 4), b0 = *(const f32x4*)(cw + DFF), b1 = *(const f32x4*)(cw + DFF + 4);
            wg[j][0] = a0[0]; wg[j][1] = a0[1]; wg[j][2] = a0[2]; wg[j][3] = a0[3]; wg[j][4] = a1[0]; wg[j][5] = a1[1]; wg[j][6] = a1[2]; wg[j][7] = a1[3];
            wv[j][0] = b0[0]; wv[j][1] = b0[1]; wv[j][2] = b0[2]; wv[j][3] = b0[3]; wv[j][4] = b1[0]; wv[j][5] = b1[1]; wv[j][6] = b1[2]; wv[j][7] = b1[3]; }
        { const f32x4 a0 = *(const f32x4*)(conv_b + c8), a1 = *(const f32x4*)(conv_b + c8 + 4), b0 = *(const f32x4*)(conv_b + DFF + c8), b1 = *(const f32x4*)(conv_b + DFF + c8 + 4);
          bg[0] = a0[0]; bg[1] = a0[1]; bg[2] = a0[2]; bg[3] = a0[3]; bg[4] = a1[0]; bg[5] = a1[1]; bg[6] = a1[2]; bg[7] = a1[3];
          bv[0] = b0[0]; bv[1] = b0[1]; bv[2] = b0[2]; bv[3] = b0[3]; bv[4] = b1[0]; bv[5] = b1[1]; bv[6] = b1[2]; bv[7] = b1[3]; }
        const int kt = u.pm % 17, bb = u.pm / 17;
#pragma unroll
        for (int ai = 0; ai < 2; ++ai) { const int rb = 2 * ai + wr;
#pragma unroll
            for (int m = 0; m < 4; ++m) {
                const int i = 128 * ai + 64 * wr + 16 * m + fr, t = 254 * kt + i - 1;
                unsigned up[8], dn[8];
#pragma unroll
                for (int e = 0; e < 8; ++e) {
                    const unsigned su = (fr == 15) ? P[ai][m > 0 ? m - 1 : 0][e] : P[ai][m][e];
                    const unsigned sd = (fr == 0) ? P[ai][m < 3 ? m + 1 : 3][e] : P[ai][m][e];
                    up[e] = (unsigned)__builtin_amdgcn_update_dpp(0, (int)su, 0x121, 0xf, 0xf, false);
                    dn[e] = (unsigned)__builtin_amdgcn_update_dpp(0, (int)sd, 0x12F, 0xf, 0xf, false);
                }
                if (m == 0 && fr == 0 && rb > 0) { const __attribute__((address_space(3))) unsigned* hp = halo + ((((rb - 1) * 2 + 1) * 4 + wc) * 4 + fq) * 8;
#pragma unroll
                    for (int e = 0; e < 8; ++e) up[e] = hp[e]; }
                if (m == 3 && fr == 15 && rb < 3) { const __attribute__((address_space(3))) unsigned* hp = halo + ((((rb + 1) * 2 + 0) * 4 + wc) * 4 + fq) * 8;
#pragma unroll
                    for (int e = 0; e < 8; ++e) dn[e] = hp[e]; }
                if (t == 0) {
#pragma unroll
                    for (int e = 0; e < 8; ++e) up[e] = 0u; }
                if (t == SEQ - 1) {
#pragma unroll
                    for (int e = 0; e < 8; ++e) dn[e] = 0u; }
                float o[8];
#pragma unroll
                for (int e2 = 0; e2 < 4; ++e2) {
                    const float g0 = bg[2 * e2] + wg[0][2 * e2] * bflo(up[e2]) + wg[1][2 * e2] * bflo(P[ai][m][e2]) + wg[2][2 * e2] * bflo(dn[e2]);
                    const float g1 = bg[2 * e2 + 1] + wg[0][2 * e2 + 1] * bfhi(up[e2]) + wg[1][2 * e2 + 1] * bfhi(P[ai][m][e2]) + wg[2][2 * e2 + 1] * bfhi(dn[e2]);
                    const float v0 = bv[2 * e2] + wv[0][2 * e2] * bflo(up[4 + e2]) + wv[1][2 * e2] * bflo(P[ai][m][4 + e2]) + wv[2][2 * e2] * bflo(dn[4 + e2]);
                    const float v1 = bv[2 * e2 + 1] + wv[0][2 * e2 + 1] * bfhi(up[4 + e2]) + wv[1][2 * e2 + 1] * bfhi(P[ai][m][4 + e2]) + wv[2][2 * e2 + 1] * bfhi(dn[4 + e2]);
                    o[2 * e2] = siluf_(g0) * v0; o[2 * e2 + 1] = siluf_(g1) * v1;
                }
                if (i >= 1 && i <= 254 && t < SEQ) {
                    u32x4 w; w.x = cvt_pk_bf16(o[0], o[1]); w.y = cvt_pk_bf16(o[2], o[3]); w.z = cvt_pk_bf16(o[4], o[5]); w.w = cvt_pk_bf16(o[6], o[7]);
                    *(u32x4*)(ACT2 + (size_t)(bb * SEQ + t) * DFF + c8) = w; }
            } }
    }
};
}

__device__ __forceinline__ void tr_item(const float* W, int ld, int k0, int col0, bf16* WT, int K, int row0, LAS float* scr, int lane, int dko = 0) {
#pragma unroll 8
    for (int i = 0; i < 32; ++i) { const int kk = 2 * i + (lane >> 5); scr[kk * 33 + (lane & 31)] = W[(size_t)(k0 + kk) * ld + col0 + (lane & 31)]; }
    LDS_WAIT(); asm volatile("" ::: "memory");
    const int c = lane & 7;
#pragma unroll
    for (int j = 0; j < 4; ++j) { const int n = (lane >> 3) + 8 * j; const LAS float* s = scr + (8 * c) * 33 + n;
        v4u o; o.x = pk2(s[0 * 33], s[1 * 33]); o.y = pk2(s[2 * 33], s[3 * 33]); o.z = pk2(s[4 * 33], s[5 * 33]); o.w = pk2(s[6 * 33], s[7 * 33]);
        *(v4u*)(WT + (size_t)(row0 + n) * K + dko + k0 + 8 * c) = o; }
    LDS_WAIT(); asm volatile("" ::: "memory");
}
#define TRJOB2(SRC, LD, KSRC, COL0, DST, KPITCH, DKO, ROW0, NCOLS) { const int nb_ = (NCOLS) / 32, ni_ = ((KSRC) / 64) * nb_; \
    if (r < ni_) { const int kb_ = r / nb_, nn_ = r % nb_; tr_item((SRC), (LD), 64 * kb_, (COL0) + 32 * nn_, (DST), (KPITCH), (ROW0) + 32 * nn_, scr, lane, (DKO)); continue; } r -= ni_; }
#define TRJOB(SRC, LD, KK, COL0, DST, ROW0, NCOLS) { const int nb_ = (NCOLS) / 32, ni_ = ((KK) / 64) * nb_; \
    if (r < ni_) { const int kb_ = r / nb_, nn_ = r % nb_; tr_item((SRC), (LD), 64 * kb_, (COL0) + 32 * nn_, (DST), (KK), (ROW0) + 32 * nn_, scr, lane); continue; } r -= ni_; }

__device__ __forceinline__ void norm_mod_row2(const float* xa, const float* xb, bool hasb, const float* nw, const float* mva, const float* mvb, int shoff, bf16* oa, bf16* ob, int lane) {
    const f32x4* xra = (const f32x4*)xa + lane; const f32x4* xrb = (const f32x4*)(hasb ? xb : xa) + lane;
    f32x4 va[8], vb[8]; float sa = 0.f, sb = 0.f;
#pragma unroll
    for (int j = 0; j < 8; ++j) { va[j] = xra[64 * j]; vb[j] = xrb[64 * j]; }
#pragma unroll
    for (int j = 0; j < 8; ++j) { sa += (va[j].x * va[j].x + va[j].y * va[j].y) + (va[j].z * va[j].z + va[j].w * va[j].w); sb += (vb[j].x * vb[j].x + vb[j].y * vb[j].y) + (vb[j].z * vb[j].z + vb[j].w * vb[j].w); }
    const float ra = rsqrtf(wave_sum(sa) * (1.f / DM) + EPS), rb = rsqrtf(wave_sum(sb) * (1.f / DM) + EPS);
#pragma unroll
    for (int j = 0; j < 8; ++j) { const int idx = 4 * (lane + 64 * j);
        const f32x4 w = *(const f32x4*)(nw + idx);
        { const f32x4 sh = *(const f32x4*)(mva + shoff + idx), sc = *(const f32x4*)(mva + shoff + DM + idx);
          const f32x4 y = (va[j] * ra * w) * (sc + 1.0f) + sh; v2u o; o.x = pk2(y.x, y.y); o.y = pk2(y.z, y.w); *(v2u*)(oa + idx) = o; }
        if (hasb) { const f32x4 sh = *(const f32x4*)(mvb + shoff + idx), sc = *(const f32x4*)(mvb + shoff + DM + idx);
          const f32x4 y = (vb[j] * rb * w) * (sc + 1.0f) + sh; v2u o; o.x = pk2(y.x, y.y); o.y = pk2(y.z, y.w); *(v2u*)(ob + idx) = o; } }
}

#define XB_TMO      128
#define XB_XCNT(j)  (256  + 64 * (j))
#define XB_XSUB(j)  (1280 + 64 * (j))
#define XB_XGEN(j)  (2304 + 64 * (j))
#define XB_TOP      3328
#define XB_TOPGEN   3392
#define XCD_BAR_WORDS 3456
#define XB_SPIN_CAP (1u << 18)

__device__ __forceinline__ unsigned xb_ld(unsigned* p)              { return __hip_atomic_load(p, __ATOMIC_RELAXED, __HIP_MEMORY_SCOPE_AGENT); }
__device__ __forceinline__ unsigned xb_add(unsigned* p, unsigned v) { return __hip_atomic_fetch_add(p, v, __ATOMIC_RELAXED, __HIP_MEMORY_SCOPE_AGENT); }
__device__ __forceinline__ unsigned xb_xcc_id() { return (unsigned)__builtin_amdgcn_s_getreg((3 << 11) | 20) & 0xFu; }
#define XB_SPIN(cond, bar) do { unsigned _sp = 0; while (cond) { __builtin_amdgcn_s_sleep(1); \
    if ((++_sp & 255u) == 0u) { if (xb_ld(&(bar)[XB_TMO])) break; if (_sp > XB_SPIN_CAP) { atomicAdd(&(bar)[XB_TMO], 1u); break; } } } } while (0)

struct XcdBarrier {
    unsigned* bar; unsigned x;
    volatile LAS unsigned* st;
};

__device__ __forceinline__ XcdBarrier xcd_barrier_post(unsigned* bar, volatile LAS unsigned* st) {
    XcdBarrier b; b.bar = bar; b.x = xb_xcc_id(); b.st = st;
    if (threadIdx.x == 0) (void)xb_add(&bar[XB_XCNT(b.x)], 1u);
    return b;
}
__device__ __forceinline__ void xcd_barrier_complete(unsigned* bar, unsigned x, unsigned& nloc, unsigned& nx) {
    const unsigned G = gridDim.x * gridDim.y * gridDim.z;
    unsigned sum, cnt, mine, sp = 0u;
    for (;;) {
        sum = 0u; cnt = 0u; mine = 0u;
#pragma unroll
        for (unsigned j = 0; j < 16; ++j) { const unsigned c = xb_ld(&bar[XB_XCNT(j)]); sum += c; cnt += (c > 0u) ? 1u : 0u; mine = (j == x) ? c : mine; }
        if (sum == G) break;
        __builtin_amdgcn_s_sleep(1);
        if ((++sp & 255u) == 0u) { if (xb_ld(&bar[XB_TMO])) break; if (sp > XB_SPIN_CAP) { atomicAdd(&bar[XB_TMO], 1u); break; } }
    }
    nloc = mine > 0u ? mine : 1u; nx = cnt > 0u ? cnt : 1u;
}

__device__ __forceinline__ void xcd_barrier(const XcdBarrier& b) {
    asm volatile("s_waitcnt vmcnt(0)" ::: "memory");
    __syncthreads();
    if (threadIdx.x == 0) {
        unsigned* bar = b.bar;
        __builtin_amdgcn_s_waitcnt(0);
        unsigned nloc = b.st[0], nx = b.st[1];
        if (nloc == 0u) { xcd_barrier_complete(bar, b.x, nloc, nx); b.st[0] = nloc; b.st[1] = nx; }
        const unsigned old = xb_add(&bar[XB_XSUB(b.x)], 1u);
        const unsigned gen = old / nloc;
        if (old + 1u == (gen + 1u) * nloc) {
            __builtin_amdgcn_fence(__ATOMIC_RELEASE, "agent");
            asm volatile("s_waitcnt vmcnt(0)" ::: "memory");
            const unsigned og = xb_add(&bar[XB_TOP], 1u);
            const unsigned tg = og / nx;
            if (og + 1u == (tg + 1u) * nx) xb_add(&bar[XB_TOPGEN], 1u);
            else XB_SPIN(xb_ld(&bar[XB_TOPGEN]) == tg, bar);
            __builtin_amdgcn_fence(__ATOMIC_ACQUIRE, "agent");
            xb_add(&bar[XB_XGEN(b.x)], 1u);
            asm volatile("s_waitcnt vmcnt(0)" ::: "memory");
        } else {
            XB_SPIN(xb_ld(&bar[XB_XGEN(b.x)]) == gen, bar);
            __builtin_amdgcn_fence(__ATOMIC_ACQUIRE, "agent");
            asm volatile("s_waitcnt vmcnt(0)" ::: "memory");
        }
    }
    __syncthreads();
}

__global__ void __launch_bounds__(NT, 2) mega_fwd(Args args) {
    extern __shared__ __attribute__((aligned(16))) unsigned char lds_raw[];
    LAS unsigned char* lds = (LAS unsigned char*)lds_raw;
    cg::grid_group grid = cg::this_grid();
    const int tid = threadIdx.x, lane = tid & 63, wave = __builtin_amdgcn_readfirstlane(tid >> 6);
    const int G_ = gridDim.x, bid = blockIdx.x;
    const int gw = bid * NW + wave, NGW = G_ * NW;
    const int lo = args.ph_lo, hi = args.ph_hi;
    const bool multi = (hi - lo) > 1;
    unsigned char* ws = args.ws;
    volatile LAS unsigned* xst = (volatile LAS unsigned*)(lds + LDS_BYTES - 16);
    if (tid < 4) xst[tid] = 0u;
    __syncthreads();
    XcdBarrier xb; xb.bar = (unsigned*)(ws + WS_BAR); xb.x = 0; xb.st = xst;
    if (multi && bid == 0) { unsigned* bw = (unsigned*)(ws + WS_BAR); for (int i = tid; i < XCD_BAR_WORDS; i += NT) bw[i] = 0u; }
#ifndef MK_RPT
#define MK_RPT 0
#endif
#define RPT(k) ((MK_RPT >> (k)) & 1)
#define IN(k) (lo <= (k) && (k) < hi)
#define SEAM(k) do { if (multi && IN((k) + 1)) { if ((k) == 0) { grid.sync(); xb = xcd_barrier_post((unsigned*)(ws + WS_BAR), xst); } else xcd_barrier(xb); } } while (0)

    const float* x = args.in[0]; const float* cvec = args.in[1]; const float* ctx = args.in[2]; const float* c_ctx = args.in[3];
    const float* w_ada = args.in[4]; const float* b_ada = args.in[5]; const float* norm1_w = args.in[6]; const float* w_in = args.in[7];
    const float* w_a_up_f = args.in[8]; const float* b_a_f = args.in[9]; const float* w_a_up_b = args.in[10]; const float* b_a_b = args.in[11];
    const float* gla_onorm_w = args.in[12]; const float* qnorm_w = args.in[13]; const float* knorm_w = args.in[14];
    const float* diff_onorm_w = args.in[19]; const float* w_proj_gla = args.in[20]; const float* w_proj_diff = args.in[21];
    const float* w_gate = args.in[22]; const float* b_gate = args.in[23]; const float* w_out = args.in[24]; const float* norm2_w = args.in[25];
    const float* w_up = args.in[26]; const float* conv_w = args.in[27]; const float* conv_b = args.in[28]; const float* w_down = args.in[29];
    float* out = args.out;
    float* MOD = (float*)(ws + WS_MOD); float* LAMP = (float*)(ws + WS_LAM);
    bf16* WCAT = (bf16*)(ws + WS_WCAT); bf16* WPG = (bf16*)(ws + WS_WPG); bf16* WPD = (bf16*)(ws + WS_WPD); bf16* WO = (bf16*)(ws + WS_WO);
    bf16* WUP = (bf16*)(ws + WS_WUP); bf16* WDN = (bf16*)(ws + WS_WDN);
    bf16* H = (bf16*)(ws + WS_H); bf16* H2 = (bf16*)(ws + WS_H2); bf16* ACT1 = (bf16*)(ws + WS_ACT1); bf16* GB = (bf16*)(ws + WS_G);
    float* LR = (float*)(ws + WS_LR); float* GDEC = (float*)(ws + WS_GDEC); float* UB = (float*)(ws + WS_U); bf16* SB = (bf16*)(ws + WS_S);
    bf16* YA = (bf16*)(ws + WS_YA); bf16* YB = (bf16*)(ws + WS_YB); float* T1 = (float*)(ws + WS_T1); bf16* MRG = (bf16*)(ws + WS_MRG);
    bf16* U2 = (bf16*)(ws + WS_U2); bf16* ACT2 = (bf16*)(ws + WS_ACT2);

    if (IN(0)) { for (int rep_ = 0; rep_ <= RPT(0); ++rep_) {
        {
            LAS float* sc = (LAS float*)lds; LAS float* red = sc + 3 * DM;
            for (int i = tid; i < 3 * DM; i += NT) { const int v = i / DM, k = i % DM; const float s = v < 2 ? cvec[v * DM + k] : c_ctx[k]; sc[i] = siluf_(s); }
            __syncthreads();
            const int cl = tid % 12, rl = tid / 12;
            for (int cb = bid; cb < 256; cb += G_) {
                f32x4 a0 = {0.f, 0.f, 0.f, 0.f}, a1 = a0, a2 = a0;
                if (tid < 504) {
                    const float* wp = w_ada + 48 * cb + 4 * cl;
                    for (int k = rl; k < DM; k += 42) { const f32x4 w = *(const f32x4*)(wp + (size_t)k * 12288); a0 += w * sc[k]; a1 += w * sc[DM + k]; a2 += w * sc[2 * DM + k]; }
                    LAS float* rp = red + (rl * 12 + cl) * 12;
#pragma unroll
                    for (int e = 0; e < 4; ++e) { rp[e] = a0[e]; rp[4 + e] = a1[e]; rp[8 + e] = a2[e]; }
                }
                __syncthreads();
                if (tid < 144) { const int cl2 = tid / 12, ve = tid % 12, v = ve >> 2, e = ve & 3; float s = 0.f;
                    for (int r2 = 0; r2 < 42; ++r2) s += red[(r2 * 12 + cl2) * 12 + ve];
                    const int n = 48 * cb + 4 * cl2 + e; MOD[v * 12288 + n] = s + b_ada[n]; }
                __syncthreads();
            }
            if (bid == 0 && tid == 0) { float s1 = 0.f, s2 = 0.f;
                for (int i = 0; i < 64; ++i) { s1 += args.in[15][i] * args.in[16][i]; s2 += args.in[17][i] * args.in[18][i]; }
                LAMP[0] = expf(s1) - expf(s2) + LAM_INIT; }
        }
        {
            LAS float* scr = (LAS float*)(lds + wave * 16384);
            constexpr int NITEMS = 2 * 32 * 96 + 32 * 128 + 32 * 1 + 2 * 16 * 64 + 32 * 64;
            for (int it = gw; it < NITEMS; it += NGW) {
                int r = it;
                TRJOB(w_in, DIN, 2048, 0, WCAT, 0, 3072)
                TRJOB(w_in, DIN, 2048, 3104, WCAT, 3072, 3072)
                { const int ni_ = 32 * 128;
                  if (r < ni_) { const int kb_ = r / 128, nb_ = r % 128, row0_ = 32 * nb_, T_ = row0_ >> 8, rr_ = row0_ & 255;
                      const int col0_ = rr_ < 128 ? 128 * T_ + rr_ : 2048 + 128 * T_ + (rr_ - 128);
                      tr_item(w_gate, 4096, 64 * kb_, col0_, WCAT, 2048, 6144 + row0_, scr, lane); continue; } r -= ni_; }
                TRJOB(w_in, DIN, 2048, 3072, WCAT, 10240, 32)
                TRJOB2(w_proj_gla, 2048, 1024, 0, WPG, 2048, 0, 0, 2048)
                TRJOB2(w_proj_diff, 2048, 1024, 0, WPG, 2048, 1024, 0, 2048)
                TRJOB(w_out, 2048, 2048, 0, WO, 0, 2048)
            }
            v4u* z = (v4u*)(WCAT + (size_t)10272 * 2048);
            for (int i = bid * NT + tid; i < 224 * 2048 / 8; i += G_ * NT) z[i] = (v4u){0u, 0u, 0u, 0u};
        }
        __syncthreads(); }
        SEAM(0);
    }

    if (IN(1)) { for (int rep_ = 0; rep_ <= RPT(1); ++rep_) {
        for (int r = gw; r < MT; r += 2 * NGW) {
            const int r2 = r + NGW; const bool hb = r2 < MT; const int rb = hb ? r2 : r;
            const float* sa = r < ML ? x + (size_t)r * DM : ctx + (size_t)(r - ML) * DM;
            const float* sb = rb < ML ? x + (size_t)rb * DM : ctx + (size_t)(rb - ML) * DM;
            norm_mod_row2(sa, sb, hb, norm1_w, MOD + (size_t)(r < ML ? r / SEQ : 2) * 12288, MOD + (size_t)(rb < ML ? rb / SEQ : 2) * 12288, 0, H + (size_t)r * DM, H + (size_t)rb * DM, lane);
        }
        __syncthreads(); }
        SEAM(1);
    }

    if (IN(2)) { for (int rep_ = 0; rep_ <= RPT(2); ++rep_) {
        pg8::Gemm g{H, WCAT, MT, NCAT, DM}; pg8::StaticOrder S; S.init(MT, NCAT, G_, bid);
        epi::EpiP2 E{ACT1, GB, LR, b_gate};
        pg8::gemm_phase<epi::EpiP2, pg8::StaticOrder, true, true>(lds, g, S, E);
        {
            const int nun = (MT / 256) * (NCAT / 256), rounds = (nun + G_ - 1) / G_, nlast = nun - (rounds - 1) * G_;
            int nidle = G_ - nlast, j = bid - nlast;
            if (nidle == 0) { nidle = G_; j = bid; }
            if (j >= 0) {
                LAS float* scr = (LAS float*)(lds + wave * 16384);
                for (int it = j * NW + wave; it < 32 * 352 + 88 * 64; it += nidle * NW) {
                    if (it < 32 * 352) { const int kb = it / 352, nb = it % 352, row0 = 32 * nb, T = row0 >> 8, rr = row0 & 255;
                        const int col0 = rr < 128 ? 128 * T + rr : DFF + 128 * T + (rr - 128);
                        tr_item(w_up, NUP, 64 * kb, col0, WUP, 2048, row0, scr, lane); }
                    else { const int r = it - 32 * 352, kb = r / 64, nb = r % 64; tr_item(w_down, 2048, 64 * kb, 32 * nb, WDN, DFF, 32 * nb, scr, lane); } }
            }
        }
        __syncthreads(); }
        SEAM(2);
    }

    if (IN(3)) { for (int rep_ = 0; rep_ <= RPT(3); ++rep_) {
        {
            LAS float* tab = (LAS float*)(lds + 131072);
            for (int i = tid; i < 1024; i += NT) { const int pos_ = i >> 4, f = i & 15;
                const float invf = exp2f(-(float)f * (13.287712379549449f / 16.f));
                float sn, cs; sincosf((float)pos_ * invf, &sn, &cs); tab[2 * i] = cs; tab[2 * i + 1] = sn; }
            __syncthreads();
            const int l8 = lane & 7;
            const bool lower = ((l8 >> 1) & 1) == 0;
            for (int wi0 = gw; wi0 < MT * 4; wi0 += 2 * NGW) {
                v4u raw[2]; bool ok[2]; bf16* ptr[2];
#pragma unroll
                for (int u = 0; u < 2; ++u) { const int wi = wi0 + u * NGW, r = wi >> 2, gi = 8 * (wi & 3) + (lane >> 3);
                    ok[u] = (wi < MT * 4) && !(r >= ML && gi < 16);
                    ptr[u] = ACT1 + (size_t)(ok[u] ? r : 0) * NACT + 3072 + 64 * gi + 8 * l8;
                    raw[u] = ok[u] ? *(const v4u*)ptr[u] : (v4u){0u, 0u, 0u, 0u}; }
#pragma unroll
                for (int u = 0; u < 2; ++u) {
                    if (!ok[u]) continue;
                    const int wi = wi0 + u * NGW, r = wi >> 2, gi = 8 * (wi & 3) + (lane >> 3);
                    const bool isq = gi < 16;
                    float y[8] = {bflo(raw[u].x), bfhi(raw[u].x), bflo(raw[u].y), bfhi(raw[u].y), bflo(raw[u].z), bfhi(raw[u].z), bflo(raw[u].w), bfhi(raw[u].w)};
                    float ss = 0.f;
#pragma unroll
                    for (int e = 0; e < 8; ++e) ss += y[e] * y[e];
                    ss += __shfl_xor(ss, 1); ss += __shfl_xor(ss, 2); ss += __shfl_xor(ss, 4);
                    const float rs = rsqrtf(ss * (1.f / 64.f) + EPS);
                    const float* nwp = (isq ? qnorm_w : knorm_w) + 8 * l8;
#pragma unroll
                    for (int e = 0; e < 8; ++e) y[e] = y[e] * rs * nwp[e];
                    if (r < ML) {
                        const int t = r & (SEQ - 1); const int pos_ = (l8 < 4) ? (t >> 6) : (t & 63);
                        const float qs = isq ? 0.125f * 1.4426950408889634f : 1.0f;
                        const LAS float* tp = tab + 2 * (pos_ * 16 + 8 * (l8 & 1));
#pragma unroll
                        for (int e = 0; e < 8; ++e) {
                            const float yp = __shfl_xor(y[e], 2);
                            const float cs = tp[2 * e], sn = tp[2 * e + 1];
                            y[e] = (lower ? (y[e] * cs - yp * sn) : (y[e] * cs + yp * sn)) * qs;
                        }
                    }
                    v4u o; o.x = pk2(y[0], y[1]); o.y = pk2(y[2], y[3]); o.z = pk2(y[4], y[5]); o.w = pk2(y[6], y[7]);
                    *(v4u*)ptr[u] = o;
                }
            }
            __syncthreads();
        }
        {
            LAS unsigned char* wl = lds + wave * 18176;
            LAS float* tot = (LAS float*)(wl + 17920);
            const int l31 = lane & 31, hh = lane >> 5, qq = (lane & 15) >> 2, pp = lane & 3, blk = (lane >> 4) & 1;
            for (int item = gw; item < NITEM1; item += NGW) {
                const int c = item % 68, chain = item / 68, dir = chain & 1, bh = chain >> 1, h = bh & 7, b = bh >> 3;
                const int R0 = (c < 4) ? ML + 256 * b + (dir ? 192 - 64 * c : 64 * c) : SEQ * b + (dir ? SEQ - 64 * (c - 3) : 64 * (c - 4));
                const float* wup = (dir ? w_a_up_b : w_a_up_f) + 64 * h + lane;
                const float bias = (dir ? b_a_b : b_a_f)[64 * h + lane];
                int lri[16];
#pragma unroll
                for (int q4 = 0; q4 < 4; ++q4) { const f32x4 t_ = *(const f32x4*)(LR + (size_t)(R0 + lane) * 32 + 16 * dir + 4 * q4);
                    lri[4 * q4] = __float_as_int(t_.x); lri[4 * q4 + 1] = __float_as_int(t_.y); lri[4 * q4 + 2] = __float_as_int(t_.z); lri[4 * q4 + 3] = __float_as_int(t_.w); }
                float wu[16];
#pragma unroll
                for (int r2 = 0; r2 < 16; ++r2) wu[r2] = wup[r2 * 512];
                { const bf16* kp = ACT1 + (size_t)(R0 + lane) * NACT + 512 + 64 * h;
#pragma unroll
                  for (int c8 = 0; c8 < 8; ++c8) *(LAS v4u*)(wl + lane * 144 + 16 * c8) = *(const v4u*)(kp + 8 * c8); }
                LDS_WAIT(); asm volatile("" ::: "memory");
                float bsum = 0.f;
                for (int p = 0; p < 64; ++p) {
                    const int rho = dir ? 63 - p : p;
                    float z = bias;
#pragma unroll
                    for (int r2 = 0; r2 < 16; ++r2) z += __int_as_float(__builtin_amdgcn_readlane(lri[r2], rho)) * wu[r2];
                    bsum += logsigf_(z) * (1.f / 16.f);
                    LAS bf16* kq = (LAS bf16*)(wl + rho * 144) + lane;
                    *kq = (bf16)f2bf(bf2f(*kq) * __expf(-bsum));
                }
                const float et = __expf(bsum);
                tot[lane] = et; GDEC[(size_t)item * 64 + lane] = et;
#pragma unroll 1
                for (int eh = 0; eh < 2; ++eh) {
                    { const bf16* vp = ACT1 + (size_t)R0 * NACT + 1024 + 128 * h + 64 * eh;
#pragma unroll
                      for (int k2 = 0; k2 < 8; ++k2) { const int idx = lane + 64 * k2, row = idx >> 3, c8 = idx & 7;
                        const v4u t = *(const v4u*)(vp + (size_t)row * NACT + 8 * c8);
                        LAS unsigned char* dp = wl + 9216 + row * 136 + 16 * c8; *(LAS v2u*)dp = (v2u){t.x, t.y}; *(LAS v2u*)(dp + 8) = (v2u){t.z, t.w}; } }
                    LDS_WAIT(); asm volatile("" ::: "memory");
#pragma unroll
                    for (int db = 0; db < 2; ++db)
#pragma unroll
                        for (int eb = 0; eb < 2; ++eb) {
                            f32x16 acc;
#pragma unroll
                            for (int i = 0; i < 16; ++i) acc[i] = 0.f;
#pragma unroll
                            for (int s = 0; s < 4; ++s) {
                                const LAS unsigned char* ap = wl + (16 * s + 4 * hh + qq) * 144 + 64 * db + 32 * blk + 8 * pp;
                                const LAS unsigned char* bp = wl + 9216 + (16 * s + 4 * hh + qq) * 136 + 64 * eb + 32 * blk + 8 * pp;
                                const s16x4 alo = __builtin_bit_cast(s16x4, __builtin_amdgcn_ds_read_tr16_b64_v4i16((LAS v4i16_t*)ap));
                                const s16x4 ahi = __builtin_bit_cast(s16x4, __builtin_amdgcn_ds_read_tr16_b64_v4i16((LAS v4i16_t*)(ap + 8 * 144)));
                                const s16x4 blo = __builtin_bit_cast(s16x4, __builtin_amdgcn_ds_read_tr16_b64_v4i16((LAS v4i16_t*)bp));
                                const s16x4 bhi = __builtin_bit_cast(s16x4, __builtin_amdgcn_ds_read_tr16_b64_v4i16((LAS v4i16_t*)(bp + 8 * 136)));
                                acc = MFMA32(__builtin_shufflevector(alo, ahi, 0, 1, 2, 3, 4, 5, 6, 7), __builtin_shufflevector(blo, bhi, 0, 1, 2, 3, 4, 5, 6, 7), acc);
                            }
                            float* up = UB + (size_t)item * 8192 + (size_t)(64 * eh + 32 * eb + l31) * 64 + 32 * db + 4 * hh;
#pragma unroll
                            for (int g4 = 0; g4 < 4; ++g4) { const f32x4 t = *(const LAS f32x4*)(tot + 32 * db + 8 * g4 + 4 * hh);
                                *(f32x4*)(up + 8 * g4) = (f32x4){acc[4 * g4] * t.x, acc[4 * g4 + 1] * t.y, acc[4 * g4 + 2] * t.z, acc[4 * g4 + 3] * t.w}; }
                        }
                    LDS_WAIT(); asm volatile("" ::: "memory");
                }
            }
        }
        __syncthreads(); }
        SEAM(3);
    }

    if (IN(4)) { for (int rep_ = 0; rep_ <= RPT(4); ++rep_) {
        {
            typedef float f32x2_ __attribute__((ext_vector_type(2)));
            for (int ti = bid * NT + tid; ti < 131072; ti += G_ * NT) {
                const int chain = ti >> 12, el = ti & 4095, e = el >> 5, d2 = (el & 31) * 2;
                f32x2_ sv = {0.f, 0.f};
                const float* up = UB + (size_t)chain * 68 * 8192 + e * 64 + d2; const float* gp = GDEC + (size_t)chain * 68 * 64 + d2;
                bf16* sp = SB + (size_t)chain * 64 * 8192 + e * 64 + d2;
#pragma unroll 1
                for (int c0 = 0; c0 < 68; c0 += 17) {
                    f32x2_ uu[17], gg[17];
#pragma unroll
                    for (int j = 0; j < 17; ++j) { uu[j] = *(const f32x2_*)(up + (size_t)(c0 + j) * 8192); gg[j] = *(const f32x2_*)(gp + (c0 + j) * 64); }
#pragma unroll
                    for (int j = 0; j < 17; ++j) { const int c = c0 + j;
                        if (c >= 4) *(unsigned*)(sp + (size_t)(c - 4) * 8192) = pk2(sv.x, sv.y);
                        sv = gg[j] * sv + uu[j]; }
                }
            }
        }
        {
            const float lam = LAMP[0];
            float kbound; { float wmx = fabsf(knorm_w[lane]);
#pragma unroll
                for (int o = 1; o < 64; o <<= 1) wmx = fmaxf(wmx, __shfl_xor(wmx, o));
                kbound = 8.f * wmx * 1.01f; }
            const int mp = wave >> 2, qw = wave & 3, l31 = lane & 31, hh = lane >> 5;
            const int qq = (lane & 15) >> 2, pp = lane & 3, blk = (lane >> 4) & 1;
            constexpr int KP = 272, VP = 320, STG = 64 * KP + 64 * VP;
            for (int un = bid; un < 512; un += G_) {
                const int b = un >> 8, h = (un >> 5) & 7, qb = un & 31;
                const int Rq = SEQ * b + 128 * qb + 32 * qw + l31;
                bf16x8 qf[4];
#pragma unroll
                for (int ks = 0; ks < 4; ++ks) qf[ks] = *(const bf16x8*)(ACT1 + (size_t)Rq * NACT + 3072 + 128 * h + 64 * mp + 16 * ks + 8 * hh);
                f32x16 O[4];
#pragma unroll
                for (int eb = 0; eb < 4; ++eb)
#pragma unroll
                    for (int i = 0; i < 16; ++i) O[eb][i] = 0.f;
                float negm; float lsum = 0.f;
                { float qn2 = 0.f;
#pragma unroll
                  for (int ks = 0; ks < 4; ++ks)
#pragma unroll
                      for (int j = 0; j < 8; ++j) { const float qv = bf2f((unsigned short)qf[ks][j]); qn2 += qv * qv; }
                  qn2 += __shfl_xor(qn2, 32);
                  negm = -sqrtf(qn2) * kbound; }
                const int srow0 = tid >> 4, sc16 = tid & 15;
                v4u stK[2], stV[2];
#define ATT_LOAD(kt) do { const int krow0_ = (kt) < 4 ? ML + 256 * b + 64 * (kt) : SEQ * b + 64 * ((kt) - 4); \
                    _Pragma("unroll") for (int p = 0; p < 2; ++p) { const bf16* src_ = ACT1 + (size_t)(krow0_ + srow0 + 32 * p) * NACT + 128 * h + 8 * sc16; \
                        stK[p] = *(const v4u*)(src_ + 4096); stV[p] = *(const v4u*)(src_ + 5120); } } while (0)
#define ATT_STORE(stg) do { _Pragma("unroll") for (int p = 0; p < 2; ++p) { LAS unsigned char* d_ = lds + (stg) * STG + (srow0 + 32 * p) * KP + 16 * sc16; \
                        *(LAS v4u*)d_ = stK[p]; *(LAS v4u*)(lds + (stg) * STG + 64 * KP + (srow0 + 32 * p) * VP + 16 * sc16) = stV[p]; } } while (0)
                ATT_LOAD(0); ATT_STORE(0);
                __syncthreads();
                for (int kt = 0; kt < 68; ++kt) {
                    if (kt + 1 < 68) ATT_LOAD(kt + 1);
                    const LAS unsigned char* Kb = lds + (kt & 1) * STG; const LAS unsigned char* Vb = Kb + 64 * KP;
                    f32x16 X[2];
#pragma unroll
                    for (int t2 = 0; t2 < 2; ++t2) {
#pragma unroll
                        for (int i = 0; i < 16; ++i) X[t2][i] = 0.f;
#pragma unroll
                        for (int ks = 0; ks < 4; ++ks) { const bf16x8 kf = *(const LAS bf16x8*)(Kb + (32 * t2 + l31) * KP + 2 * (64 * mp + 16 * ks + 8 * hh)); X[t2] = MFMA32(kf, qf[ks], X[t2]); }
                    }
                    float ps = 0.f;
#pragma unroll
                    for (int t2 = 0; t2 < 2; ++t2)
#pragma unroll
                        for (int i = 0; i < 16; ++i) { const float p = __builtin_amdgcn_exp2f(X[t2][i] + negm); X[t2][i] = p; ps += p; }
                    lsum += ps;
#pragma unroll
                    for (int t2 = 0; t2 < 2; ++t2)
#pragma unroll
                        for (int s = 0; s < 2; ++s) {
                            v4u pk; pk.x = pk2(X[t2][8 * s + 0], X[t2][8 * s + 1]); pk.y = pk2(X[t2][8 * s + 2], X[t2][8 * s + 3]);
                            pk.z = pk2(X[t2][8 * s + 4], X[t2][8 * s + 5]); pk.w = pk2(X[t2][8 * s + 6], X[t2][8 * s + 7]);
                            const bf16x8 pf = __builtin_bit_cast(bf16x8, pk);
                            const LAS unsigned char* vrow = Vb + (32 * t2 + 16 * s + 4 * hh + qq) * VP + 32 * blk + 8 * pp;
#pragma unroll
                            for (int eb = 0; eb < 4; ++eb) {
                                const s16x4 vlo = __builtin_bit_cast(s16x4, __builtin_amdgcn_ds_read_tr16_b64_v4i16((LAS v4i16_t*)(vrow + 64 * eb)));
                                const s16x4 vhi = __builtin_bit_cast(s16x4, __builtin_amdgcn_ds_read_tr16_b64_v4i16((LAS v4i16_t*)(vrow + 8 * VP + 64 * eb)));
                                const bf16x8 vf = __builtin_shufflevector(vlo, vhi, 0, 1, 2, 3, 4, 5, 6, 7);
                                O[eb] = MFMA32(vf, pf, O[eb]);
                            }
                        }
                    if (kt + 1 < 68) ATT_STORE((kt + 1) & 1);
                    __syncthreads();
                }
#undef ATT_LOAD
#undef ATT_STORE
                lsum += __shfl_xor(lsum, 32);
                const float inv = 1.f / lsum;
                LAS float* ob = (LAS float*)lds;
                if (mp == 1) {
                    const float sc = inv * lam;
#pragma unroll
                    for (int eb = 0; eb < 4; ++eb)
#pragma unroll
                        for (int i = 0; i < 16; ++i) ob[(32 * qw + l31) * 132 + 32 * eb + crow(i, hh)] = O[eb][i] * sc;
                }
                __syncthreads();
                if (mp == 0) {
                    float ss = 0.f;
#pragma unroll
                    for (int eb = 0; eb < 4; ++eb)
#pragma unroll
                        for (int i = 0; i < 16; ++i) { const float v = O[eb][i] * inv - ob[(32 * qw + l31) * 132 + 32 * eb + crow(i, hh)]; O[eb][i] = v; ss += v * v; }
                    ss += __shfl_xor(ss, 32);
                    const float rs = rsqrtf(ss * (1.f / 128.f) + EPS) * (1.f - LAM_INIT);
                    bf16* yp = YA + (size_t)Rq * 2048 + 1024 + 128 * h;
#pragma unroll
                    for (int eb = 0; eb < 4; ++eb)
#pragma unroll
                        for (int g4 = 0; g4 < 4; ++g4) { const int e0 = 32 * eb + 8 * g4 + 4 * hh; const f32x4 w = *(const f32x4*)(diff_onorm_w + e0);
                            v2u o; o.x = pk2(O[eb][4 * g4 + 0] * rs * w.x, O[eb][4 * g4 + 1] * rs * w.y); o.y = pk2(O[eb][4 * g4 + 2] * rs * w.z, O[eb][4 * g4 + 3] * rs * w.w);
                            *(v2u*)(yp + e0) = o; }
                }
                __syncthreads();
            }
        }
        __syncthreads(); }
        SEAM(4);
    }

    if (IN(5)) { for (int rep_ = 0; rep_ <= RPT(5); ++rep_) {
        const int g = tid >> 8, gwv = wave & 3, gt = tid & 255;
        LAS unsigned char* gl = lds + g * 55808;
        LAS float* xch = (LAS float*)(gl + 53248);
        const int l31 = lane & 31, hh = lane >> 5, qq = (lane & 15) >> 2, pp = lane & 3, blk = (lane >> 4) & 1;
        const int ib = gwv & 1, eh = gwv >> 1, itok = 32 * ib + l31;
        for (int pi = bid; pi < 512; pi += G_) {
            const int item = 2 * pi + g, m = item & 63, bh = item >> 6, h = bh & 7, b = bh >> 3, R0 = SEQ * b + 64 * m;
            bf16x8 Sfr[2][8]; v2u rr[2][4];
#pragma unroll
            for (int eb = 0; eb < 2; ++eb) {
#pragma unroll
                for (int ks = 0; ks < 8; ++ks) { const int dir = ks >> 2;
                    Sfr[eb][ks] = *(const bf16x8*)(SB + ((size_t)(bh * 2 + dir) * 64 + (dir ? 63 - m : m)) * 8192 + (size_t)(64 * eh + 32 * eb + l31) * 64 + 16 * (ks & 3) + 8 * hh); }
#pragma unroll
                for (int g4 = 0; g4 < 4; ++g4) rr[eb][g4] = *(const v2u*)(ACT1 + (size_t)(R0 + itok) * NACT + 2048 + 128 * h + 64 * eh + 32 * eb + 8 * g4 + 4 * hh);
            }
            {
                const int rw0 = 16 * gwv;
                float wuf[16], wub[16];
#pragma unroll
                for (int r2 = 0; r2 < 16; ++r2) { wuf[r2] = w_a_up_f[r2 * 512 + 64 * h + lane]; wub[r2] = w_a_up_b[r2 * 512 + 64 * h + lane]; }
                const float biasf = b_a_f[64 * h + lane], biasb = b_a_b[64 * h + lane];
                int lri[32];
#pragma unroll
                for (int q4 = 0; q4 < 8; ++q4) { const f32x4 t_ = *(const f32x4*)(LR + (size_t)(R0 + rw0 + (lane & 15)) * 32 + 4 * q4);
                    lri[4 * q4] = __float_as_int(t_.x); lri[4 * q4 + 1] = __float_as_int(t_.y); lri[4 * q4 + 2] = __float_as_int(t_.z); lri[4 * q4 + 3] = __float_as_int(t_.w); }
                unsigned short qraw[16], kraw[16];
                { const bf16* qp = ACT1 + (size_t)(R0 + rw0) * NACT + 64 * h + lane;
#pragma unroll
                  for (int i = 0; i < 16; ++i) { qraw[i] = qp[(size_t)i * NACT]; kraw[i] = qp[(size_t)i * NACT + 512]; } }
                { const bf16* vp = ACT1 + (size_t)(R0 + rw0) * NACT + 1024 + 128 * h;
#pragma unroll
                  for (int k2 = 0; k2 < 4; ++k2) { const int idx = lane + 64 * k2, row = idx >> 4, c16 = idx & 15;
                    *(LAS v4u*)(gl + 35840 + (rw0 + row) * 272 + 16 * c16) = *(const v4u*)(vp + (size_t)row * NACT + 8 * c16); } }
                float cf[16], cb[16];
#pragma unroll
                for (int i = 0; i < 16; ++i) { float zf = biasf, zb = biasb;
#pragma unroll
                    for (int r2 = 0; r2 < 16; ++r2) { zf += __int_as_float(__builtin_amdgcn_readlane(lri[r2], i)) * wuf[r2]; zb += __int_as_float(__builtin_amdgcn_readlane(lri[16 + r2], i)) * wub[r2]; }
                    cf[i] = logsigf_(zf) * (1.f / 16.f); cb[i] = logsigf_(zb) * (1.f / 16.f); }
#pragma unroll
                for (int i = 1; i < 16; ++i) cf[i] += cf[i - 1];
#pragma unroll
                for (int i = 14; i >= 0; --i) cb[i] += cb[i + 1];
                LAS float* segp = (LAS float*)(gl + 53248 + 512);
                segp[gwv * 64 + lane] = cf[15]; segp[256 + gwv * 64 + lane] = cb[0];
                __syncthreads();
                float offf = 0.f, offb = 0.f;
#pragma unroll
                for (int w2 = 0; w2 < 4; ++w2) { if (w2 < gwv) offf += segp[w2 * 64 + lane]; if (w2 > gwv) offb += segp[256 + w2 * 64 + lane]; }
#pragma unroll
                for (int i = 0; i < 16; ++i) { const int rho = rw0 + i;
                    const float ef = __expf(offf + cf[i]), eb_ = __expf(offb + cb[i]); const float qv = bf2f(qraw[i]), kv = bf2f(kraw[i]);
                    LAS bf16* qe = (LAS bf16*)(gl + rho * 272) + lane; LAS bf16* ke = (LAS bf16*)(gl + 17408 + rho * 144) + lane;
                    qe[0] = (bf16)f2bf(qv * ef); qe[64] = (bf16)f2bf(qv * eb_);
                    ke[0] = (bf16)f2bf(kv * __builtin_amdgcn_rcpf(ef)); ke[4608] = (bf16)f2bf(kv * __builtin_amdgcn_rcpf(eb_)); }
            }
            __syncthreads();
            bf16x8 qf[8];
#pragma unroll
            for (int ks = 0; ks < 8; ++ks) qf[ks] = *(const LAS bf16x8*)(gl + itok * 272 + 2 * (16 * ks + 8 * hh));
            bf16x8 pf[2][2];
#pragma unroll
            for (int jb = 0; jb < 2; ++jb) {
                f32x16 Xf, Xb;
#pragma unroll
                for (int i = 0; i < 16; ++i) { Xf[i] = 0.f; Xb[i] = 0.f; }
                if (jb <= ib) {
#pragma unroll
                    for (int ks = 0; ks < 4; ++ks) { const bf16x8 kf = *(const LAS bf16x8*)(gl + 17408 + (32 * jb + l31) * 144 + 2 * (16 * ks + 8 * hh)); Xf = MFMA32(kf, qf[ks], Xf); } }
                if (jb >= ib) {
#pragma unroll
                    for (int ks = 0; ks < 4; ++ks) { const bf16x8 kb = *(const LAS bf16x8*)(gl + 26624 + (32 * jb + l31) * 144 + 2 * (16 * ks + 8 * hh)); Xb = MFMA32(kb, qf[4 + ks], Xb); } }
                float pv[16];
#pragma unroll
                for (int r2 = 0; r2 < 16; ++r2) { const int j = 32 * jb + crow(r2, hh); pv[r2] = ((j <= itok) ? Xf[r2] : 0.f) + ((j >= itok) ? Xb[r2] : 0.f); }
#pragma unroll
                for (int s = 0; s < 2; ++s) { v4u pk; pk.x = pk2(pv[8 * s], pv[8 * s + 1]); pk.y = pk2(pv[8 * s + 2], pv[8 * s + 3]); pk.z = pk2(pv[8 * s + 4], pv[8 * s + 5]); pk.w = pk2(pv[8 * s + 6], pv[8 * s + 7]);
                    pf[jb][s] = __builtin_bit_cast(bf16x8, pk); }
            }
            f32x16 O[2]; float ss = 0.f;
#pragma unroll
            for (int eb = 0; eb < 2; ++eb) {
                f32x16 acc;
#pragma unroll
                for (int i = 0; i < 16; ++i) acc[i] = 0.f;
#pragma unroll
                for (int ks = 0; ks < 8; ++ks) acc = MFMA32(Sfr[eb][ks], qf[ks], acc);
#pragma unroll
                for (int jb = 0; jb < 2; ++jb)
#pragma unroll
                    for (int s = 0; s < 2; ++s) {
                        const LAS unsigned char* vp = gl + 35840 + (32 * jb + 16 * s + 4 * hh + qq) * 272 + 2 * (64 * eh + 32 * eb) + 32 * blk + 8 * pp;
                        const s16x4 vlo = __builtin_bit_cast(s16x4, __builtin_amdgcn_ds_read_tr16_b64_v4i16((LAS v4i16_t*)vp));
                        const s16x4 vhi = __builtin_bit_cast(s16x4, __builtin_amdgcn_ds_read_tr16_b64_v4i16((LAS v4i16_t*)(vp + 8 * 272)));
                        acc = MFMA32(__builtin_shufflevector(vlo, vhi, 0, 1, 2, 3, 4, 5, 6, 7), pf[jb][s], acc);
                    }
                O[eb] = acc;
#pragma unroll
                for (int i = 0; i < 16; ++i) ss += acc[i] * acc[i];
            }
            ss += __shfl_xor(ss, 32);
            if (hh == 0) xch[gwv * 32 + l31] = ss;
            __syncthreads();
            const float rs = rsqrtf((ss + xch[(gwv ^ 2) * 32 + l31]) * (1.f / 128.f) + EPS);
            bf16* yp = YA + (size_t)(R0 + itok) * 2048 + 128 * h + 64 * eh + 4 * hh;
#pragma unroll
            for (int eb = 0; eb < 2; ++eb)
#pragma unroll
                for (int g4 = 0; g4 < 4; ++g4) { const int e0 = 64 * eh + 32 * eb + 8 * g4 + 4 * hh; const f32x4 w = *(const f32x4*)(gla_onorm_w + e0); const v2u r_ = rr[eb][g4];
                    v2u o; o.x = pk2(O[eb][4 * g4] * rs * w.x * siluf_(bflo(r_.x)), O[eb][4 * g4 + 1] * rs * w.y * siluf_(bfhi(r_.x)));
                    o.y = pk2(O[eb][4 * g4 + 2] * rs * w.z * siluf_(bflo(r_.y)), O[eb][4 * g4 + 3] * rs * w.w * siluf_(bfhi(r_.y)));
                    *(v2u*)(yp + 32 * eb + 8 * g4) = o; }
        }
        __syncthreads(); }
        SEAM(5);
    }

    if (IN(6)) { for (int rep_ = 0; rep_ <= RPT(6); ++rep_) {
        pg8::Gemm g{YA, WPG, ML, DM, DM}; pg8::StaticOrder S; S.init(ML, DM, G_, bid);
        epi::EpiMrg2 E{GB, MRG};
        pg8::gemm_phase<epi::EpiMrg2, pg8::StaticOrder, false, true>(lds, g, S, E);
        __syncthreads(); }
        SEAM(6);
    }

    if (IN(7)) { for (int rep_ = 0; rep_ <= RPT(7); ++rep_) {
        pg8::Gemm g{MRG, WO, ML, DM, DM}; pg8::StaticOrder S; S.init(ML, DM, G_, bid);
        epi::EpiRes E{x, out, MOD + 2 * DM};
        pg8::gemm_phase<epi::EpiRes, pg8::StaticOrder, false, true>(lds, g, S, E);
        __syncthreads(); }
        SEAM(7);
    }

    if (IN(8)) { for (int rep_ = 0; rep_ <= RPT(8); ++rep_) {
        for (int r = gw; r < ML; r += 2 * NGW) {
            const int r2 = r + NGW; const bool hb = r2 < ML; const int rb = hb ? r2 : r;
            norm_mod_row2(out + (size_t)r * DM, out + (size_t)rb * DM, hb, norm2_w, MOD + (size_t)(r / SEQ) * 12288, MOD + (size_t)(rb / SEQ) * 12288, 3 * DM, H2 + (size_t)r * DM, H2 + (size_t)rb * DM, lane);
        }
        __syncthreads(); }
        SEAM(8);
    }

    if (IN(9)) { for (int rep_ = 0; rep_ <= RPT(9); ++rep_) {
        pg8::Gemm g{H2, WUP, 34 * 256, NUP, DM}; pg8::StaticOrder S; S.init(34 * 256, NUP, G_, bid); S.conv = 1;
        epi::EpiConv E{ACT2, conv_w, conv_b, (LAS unsigned*)(lds + 131072)};
        pg8::gemm_phase<epi::EpiConv, pg8::StaticOrder, true, true>(lds, g, S, E);
        __syncthreads(); }
        SEAM(9);
    }

    if (IN(10)) { for (int rep_ = 0; rep_ <= RPT(10); ++rep_) {
        pg8::Gemm g{ACT2, WDN, ML, DM, DFF}; pg8::StaticOrder S; S.init(ML, DM, G_, bid);
        epi::EpiRes E{out, out, MOD + 5 * DM};
        pg8::gemm_phase<epi::EpiRes, pg8::StaticOrder, false, true>(lds, g, S, E);
    } }
#undef IN
#undef SEAM
}

#ifndef MK_SPLIT
#define MK_SPLIT 0
#endif
constexpr int NPHASE = 11;
#ifndef MK_RPTH
#define MK_RPTH 0
#endif
extern "C" void kernel_launch(void* const* d_in, const int* in_sizes, int n_in, void* d_out, int out_size, void* d_ws, size_t ws_size, hipStream_t stream) {
    static int grid = 0;
    if (grid == 0) {
        if (n_in != 30 || out_size != ML * DM || ws_size < WS_END) { fprintf(stderr, "kernel_launch: unexpected problem (n_in %d out %d ws %zu)\n", n_in, out_size, ws_size); grid = -1; return; }
        int dev = 0, cus = 0, per_cu = 0;
        hipGetDevice(&dev); hipDeviceGetAttribute(&cus, hipDeviceAttributeMultiprocessorCount, dev);
        if (hipFuncSetAttribute((const void*)mega_fwd, hipFuncAttributeMaxDynamicSharedMemorySize, LDS_BYTES) != hipSuccess) { fprintf(stderr, "kernel_launch: hipFuncSetAttribute failed\n"); grid = -1; return; }
        if (hipOccupancyMaxActiveBlocksPerMultiprocessor(&per_cu, (const void*)mega_fwd, NT, LDS_BYTES) != hipSuccess || per_cu < 1) per_cu = 1;
        (void)hipGetLastError();
        grid = cus * per_cu;
    }
    if (grid < 0) return;
    Args a{};
    for (int i = 0; i < 30; ++i) a.in[i] = (const float*)d_in[i];
    a.out = (float*)d_out; a.ws = (unsigned char*)d_ws;
#if MK_SPLIT
    for (int p = 0; p < NPHASE; ++p) for (int q = 0; q <= ((MK_RPTH >> p) & 1); ++q) { a.ph_lo = p; a.ph_hi = p + 1; hipLaunchKernelGGL(mega_fwd, dim3(grid), dim3(NT), LDS_BYTES, stream, a); }
#else
    a.ph_lo = 0; a.ph_hi = NPHASE;
    void* kargs[] = {&a};
    hipError_t e = hipLaunchCooperativeKernel((const void*)mega_fwd, dim3(grid), dim3(NT), kargs, LDS_BYTES, stream);
    if (e != hipSuccess) fprintf(stderr, "cooperative launch failed: %s (grid %d)\n", hipGetErrorString(e), grid);
#endif
}
```

```cpp
#include <hip/hip_runtime.h>
#include <hip/hip_cooperative_groups.h>
#include <cstdio>
#include <cstdint>
namespace cg = cooperative_groups;
namespace pg8 {
#define PG8_LAS __attribute__((address_space(3)))
typedef unsigned short bf16_t;
typedef short bf16x8 __attribute__((ext_vector_type(8)));
typedef float f32x4 __attribute__((ext_vector_type(4)));
typedef unsigned u32x4 __attribute__((ext_vector_type(4)));
constexpr int BM = 256, BK = 64, HALF = 128, HTB = HALF * BK * 2  , STAGE_BYTES = 8 * HTB, NXCD = 8, WGM = 8;

__host__ __device__ __forceinline__ int lds_byte(int r, int c) { const int st = (r >> 4) * 2 + (c >> 5), rr = r & 15, cc = c & 31, ob = rr * 64 + cc * 2; return st * 1024 + (ob ^ (((ob >> 9) & 1) << 5)); }
__host__ __device__ __forceinline__ void stage_rc(int b, int& R, int& C) { const int st = b / 1024, sb = b % 1024, swz = sb ^ (((sb >> 9) & 1) << 5); R = (st >> 1) * 16 + swz / 64; C = (st & 1) * 32 + (swz % 64) / 2; }
__host__ __device__ __forceinline__ int perm32(int rho) { const int n = rho >> 4, i = rho & 15; return 8 * (i >> 2) + 4 * n + (i & 3); }

struct Unit { int pm, pn; };
struct Gemm { const bf16_t* A; const bf16_t* Bt; int M, N, K; };

struct StaticOrder {
    int nM, nN, nwg, G, c, conv;
    __host__ __device__ void init(int M, int N, int G_, int c_) { nM = M / BM; nN = N / BM; nwg = nM * nN; G = G_; c = c_; conv = 0; }
    __host__ __device__ long arow(int pm) const { return conv ? (long)(pm / 17) * 4096 + 254 * (pm % 17) - 1 : (long)pm * BM; }
    __host__ __device__ bool next(int i, Unit& u) const {
        const long L = (long)i * G + c; if (L >= nwg) return false;
        int wgid = (int)L; { const int q = nwg / NXCD, r = nwg % NXCD, xcd = wgid % NXCD, off = wgid / NXCD; wgid = (xcd < r ? xcd * (q + 1) : r * (q + 1) + (xcd - r) * q) + off; }
        const int nig = WGM * nN, gid = wgid / nig, fm = gid * WGM, gsz = (nM - fm) < WGM ? (nM - fm) : WGM;
        u.pm = fm + ((wgid % nig) % gsz); u.pn = (wgid % nig) / gsz; return true;
    }
    __device__ __forceinline__ void a_ready(const Unit&) const {}
    __device__ __forceinline__ void done(const Unit&) const {}
};

typedef float f32x2c_t __attribute__((ext_vector_type(2))); typedef __bf16 bf16x2c_t __attribute__((ext_vector_type(2)));
__device__ __forceinline__ unsigned cvt_pk_bf16(float lo, float hi) { f32x2c_t v = {lo, hi}; bf16x2c_t b = __builtin_convertvector(v, bf16x2c_t); return __builtin_bit_cast(unsigned, b); }

template <class Epi, class Sched, bool ALIGN_EPI = false, bool SP2 = false>
__device__ __forceinline__ void gemm_phase(PG8_LAS unsigned char* lds, const Gemm g, const Sched& S, const Epi& E) {
    const int tid = threadIdx.x, wid = __builtin_amdgcn_readfirstlane(tid >> 6), lane = tid & 63, wr = wid >> 2, wc = wid & 3, fr = lane & 15, fq = lane >> 4;
    const int K = g.K, nt = K / BK;
    unsigned voffA[2], voffB[2];
#pragma unroll
    for (int i = 0; i < 2; ++i) { int R, C; stage_rc(tid * 16 + i * 8192, R, C); const int Rb = Epi::PERM ? ((R & ~31) + perm32(R & 31)) : R;
        voffA[i] = (unsigned)(R * K + C) * 2u; voffB[i] = (unsigned)(Rb * K + C) * 2u; }
    const size_t kstep = (size_t)(BK * 2);
    const size_t hstep = (size_t)HALF * K * 2;
    const size_t tstep = 2 * hstep;
    const unsigned ldsw = (unsigned)wid * 1024u;
    const int aoff = lds_byte(wr * 64 + fr, fq * 8), boff = lds_byte(wc * 32 + fr, fq * 8);
#define PG8_SA(b, h) (((b) * 2 + (h)) * HTB)
#define PG8_SB(b, h) ((4 + (b) * 2 + (h)) * HTB)
#define PG8_STAGE(bufoff, gbase, voff) do { _Pragma("unroll") for (int _i = 0; _i < 2; ++_i) \
        __builtin_amdgcn_global_load_lds((const unsigned*)((const char*)(gbase) + (voff)[_i]), (PG8_LAS unsigned*)(lds + (bufoff) + ldsw + _i * 8192), 16, 0, 0); } while (0)
#define PG8_LDA(dst, b, h) do { _Pragma("unroll") for (int m = 0; m < 4; ++m) _Pragma("unroll") for (int k = 0; k < 2; ++k) dst[m][k] = *(const PG8_LAS bf16x8*)(lds + PG8_SA(b, h) + aoff + m * 2048 + k * 1024); } while (0)
#define PG8_LDB(dst, b, h) do { _Pragma("unroll") for (int n = 0; n < 2; ++n) _Pragma("unroll") for (int k = 0; k < 2; ++k) dst[n][k] = *(const PG8_LAS bf16x8*)(lds + PG8_SB(b, h) + boff + n * 2048 + k * 1024); } while (0)
#define PG8_MMA(ai, bj, At, Bt) do { __builtin_amdgcn_s_setprio(1); _Pragma("unroll") for (int m = 0; m < 4; ++m) _Pragma("unroll") for (int n = 0; n < 2; ++n) _Pragma("unroll") for (int k = 0; k < 2; ++k) \
        acc[ai][bj][m][n] = __builtin_amdgcn_mfma_f32_16x16x32_bf16(Bt[n][k], At[m][k], acc[ai][bj][m][n], 0, 0, 0); __builtin_amdgcn_s_setprio(0); } while (0)
#define PG8_WAIT_V(n) asm volatile("s_waitcnt vmcnt(" #n ")" ::: "memory")
#define PG8_WAIT_L(n) asm volatile("s_waitcnt lgkmcnt(" #n ")" ::: "memory")
#define PG8_BAR __builtin_amdgcn_s_barrier()
#define PG8_SCHED __builtin_amdgcn_sched_barrier(0)
    Unit cur, nxt; int ui = 0;
    if (!S.next(0, cur)) return;
    f32x4 acc[2][2][4][2];
#pragma unroll
    for (int a = 0; a < 2; ++a)
#pragma unroll
        for (int b = 0; b < 2; ++b)
#pragma unroll
            for (int m = 0; m < 4; ++m)
#pragma unroll
                for (int n = 0; n < 2; ++n) acc[a][b][m][n] = (f32x4){0.f, 0.f, 0.f, 0.f};
    bf16x8 At[4][2], B0[2][2], B1[2][2];
    const char* cA = (const char*)g.A + S.arow(cur.pm) * (long)K * 2; const char* cB = (const char*)g.Bt + (size_t)cur.pn * tstep;
    S.a_ready(cur);
    if constexpr (SP2) {
        PG8_STAGE(PG8_SB(0, 0), cB, voffB); PG8_STAGE(PG8_SB(0, 1), cB + hstep, voffB); PG8_STAGE(PG8_SA(0, 0), cA, voffA); PG8_STAGE(PG8_SA(0, 1), cA + hstep, voffA);
        if (wr == 1) PG8_BAR;
        PG8_WAIT_V(2); PG8_BAR;
        PG8_STAGE(PG8_SB(1, 0), cB + kstep, voffB); PG8_STAGE(PG8_SA(1, 0), cA + kstep, voffA); PG8_STAGE(PG8_SB(1, 1), cB + hstep + kstep, voffB);
        PG8_WAIT_V(6); PG8_BAR;
    } else {
        PG8_STAGE(PG8_SB(0, 0), cB, voffB); PG8_STAGE(PG8_SA(0, 0), cA, voffA); PG8_STAGE(PG8_SB(0, 1), cB + hstep, voffB); PG8_STAGE(PG8_SA(0, 1), cA + hstep, voffA);
        if (wr == 1) PG8_BAR;
        PG8_WAIT_V(4); PG8_BAR;
        PG8_STAGE(PG8_SB(1, 0), cB + kstep, voffB); PG8_STAGE(PG8_SA(1, 0), cA + kstep, voffA); PG8_STAGE(PG8_SB(1, 1), cB + hstep + kstep, voffB);
        PG8_WAIT_V(6); PG8_BAR;
    }
    for (;;) {
        const bool has_next = S.next(ui + 1, nxt);
        const char* nA = has_next ? (const char*)g.A + S.arow(nxt.pm) * (long)K * 2 : cA; const char* nB = has_next ? (const char*)g.Bt + (size_t)nxt.pn * tstep : cB;
        for (int t = 0; t < nt; t += 2) {
            if constexpr (Epi::MIDK > 0) { if (t == Epi::MIDK) E.mid(acc, cur, wr, wc, fr, fq); }
            const bool last = (t == nt - 2);
            const char* a1 = cA + (size_t)(t + 1) * kstep;
            const char* a2 = last ? nA : cA + (size_t)(t + 2) * kstep; const char* b2 = last ? nB : cB + (size_t)(t + 2) * kstep;
            const char* a3 = a2 + kstep; const char* b3 = b2 + kstep;
            if (last && has_next) S.a_ready(nxt);
            if constexpr (SP2) {
            PG8_LDB(B0, 0, 0); PG8_LDB(B1, 0, 1); PG8_SCHED; PG8_LDA(At, 0, 0); PG8_STAGE(PG8_SA(1, 1), a1 + hstep, voffA);
            PG8_WAIT_V(8); PG8_WAIT_L(0); PG8_BAR; PG8_MMA(0, 0, At, B0); PG8_MMA(0, 1, At, B1); PG8_BAR; PG8_SCHED;
            PG8_LDA(At, 0, 1); PG8_STAGE(PG8_SB(0, 0), b2, voffB); PG8_STAGE(PG8_SB(0, 1), b2 + hstep, voffB); PG8_STAGE(PG8_SA(0, 0), a2, voffA);
            PG8_WAIT_V(8); PG8_WAIT_L(0); PG8_BAR; PG8_MMA(1, 0, At, B0); PG8_MMA(1, 1, At, B1); PG8_BAR; PG8_SCHED;
            PG8_LDB(B0, 1, 0); PG8_LDB(B1, 1, 1); PG8_SCHED; PG8_LDA(At, 1, 0); PG8_STAGE(PG8_SA(0, 1), a2 + hstep, voffA);
            PG8_WAIT_V(8); PG8_WAIT_L(0); PG8_BAR; PG8_MMA(0, 0, At, B0); PG8_MMA(0, 1, At, B1); PG8_BAR; PG8_SCHED;
            PG8_LDA(At, 1, 1); PG8_STAGE(PG8_SB(1, 0), b3, voffB); PG8_STAGE(PG8_SB(1, 1), b3 + hstep, voffB); PG8_STAGE(PG8_SA(1, 0), a3, voffA);
            PG8_WAIT_V(8); PG8_WAIT_L(0); PG8_BAR; PG8_MMA(1, 0, At, B0); PG8_MMA(1, 1, At, B1); PG8_BAR; PG8_SCHED;
            } else {
            PG8_LDB(B0, 0, 0); PG8_SCHED; PG8_LDA(At, 0, 0); PG8_STAGE(PG8_SA(1, 1), a1 + hstep, voffA);
            PG8_WAIT_L(8); PG8_BAR; PG8_WAIT_L(0); PG8_MMA(0, 0, At, B0); PG8_BAR; PG8_SCHED;
            PG8_LDB(B1, 0, 1); PG8_STAGE(PG8_SB(0, 0), b2, voffB);
            PG8_BAR; PG8_WAIT_L(0); PG8_MMA(0, 1, At, B1); PG8_BAR;
            PG8_LDA(At, 0, 1); PG8_STAGE(PG8_SA(0, 0), a2, voffA);
            PG8_BAR; PG8_WAIT_L(0); PG8_MMA(1, 0, At, B0); PG8_BAR; PG8_SCHED;
            PG8_STAGE(PG8_SB(0, 1), b2 + hstep, voffB);
            PG8_WAIT_V(6); PG8_BAR; PG8_MMA(1, 1, At, B1); PG8_BAR;
            PG8_LDB(B0, 1, 0); PG8_SCHED; PG8_LDA(At, 1, 0); PG8_STAGE(PG8_SA(0, 1), a2 + hstep, voffA);
            PG8_WAIT_L(8); PG8_BAR; PG8_WAIT_L(0); PG8_MMA(0, 0, At, B0); PG8_BAR; PG8_SCHED;
            PG8_LDB(B1, 1, 1); PG8_STAGE(PG8_SB(1, 0), b3, voffB);
            PG8_BAR; PG8_WAIT_L(0); PG8_MMA(0, 1, At, B1); PG8_BAR;
            PG8_LDA(At, 1, 1); PG8_STAGE(PG8_SA(1, 0), a3, voffA);
            PG8_BAR; PG8_WAIT_L(0); PG8_MMA(1, 0, At, B0); PG8_BAR; PG8_SCHED;
            PG8_STAGE(PG8_SB(1, 1), b3 + hstep, voffB);
            PG8_WAIT_V(6); PG8_BAR; PG8_MMA(1, 1, At, B1); PG8_BAR;
            }
        }
        if constexpr (ALIGN_EPI) { if (wr == 0) PG8_BAR; }
        if constexpr (!Epi::AFTER_DRAIN) { E(acc, cur, wr, wc, fr, fq); S.done(cur); }
        if (!has_next) break;
#pragma unroll
        for (int a = 0; a < 2; ++a)
#pragma unroll
            for (int b = 0; b < 2; ++b)
#pragma unroll
                for (int m = 0; m < 4; ++m)
#pragma unroll
                    for (int n = 0; n < 2; ++n) acc[a][b][m][n] = (f32x4){0.f, 0.f, 0.f, 0.f};
        cur = nxt; cA = nA; cB = nB; ++ui;
        if constexpr (ALIGN_EPI) { if (wr == 1) PG8_BAR; }
    }
    PG8_WAIT_V(0);
    if constexpr (!ALIGN_EPI) { if (wr == 0) PG8_BAR; }
    PG8_BAR;
    if constexpr (Epi::AFTER_DRAIN) { E.fused(acc, cur, wr, wc, fr, fq, lds, wid, lane); S.done(cur); }
#undef PG8_SA
#undef PG8_SB
#undef PG8_STAGE
#undef PG8_LDA
#undef PG8_LDB
#undef PG8_MMA
#undef PG8_WAIT_V
#undef PG8_WAIT_L
#undef PG8_BAR
#undef PG8_SCHED
}
}

#define GAS __attribute__((address_space(1)))
#define LAS __attribute__((address_space(3)))
typedef unsigned short bf16;
typedef unsigned v4u __attribute__((ext_vector_type(4)));
typedef unsigned v2u __attribute__((ext_vector_type(2)));
typedef float f32x4 __attribute__((ext_vector_type(4)));
typedef float f32x16 __attribute__((ext_vector_type(16)));
typedef short bf16x8 __attribute__((ext_vector_type(8)));
typedef short s16x4 __attribute__((ext_vector_type(4)));
typedef short v4i16_t __attribute__((ext_vector_type(4)));
#define LDS_WAIT() asm volatile("s_waitcnt lgkmcnt(0)" ::: "memory")
#define MFMA16(a, b, c) __builtin_amdgcn_mfma_f32_16x16x32_bf16((a), (b), (c), 0, 0, 0)
#define MFMA32(a, b, c) __builtin_amdgcn_mfma_f32_32x32x16_bf16((a), (b), (c), 0, 0, 0)

typedef float f32x2_t __attribute__((ext_vector_type(2))); typedef __bf16 bf16x2_t __attribute__((ext_vector_type(2)));
__device__ __forceinline__ unsigned pk2(float lo, float hi) { f32x2_t v = {lo, hi}; bf16x2_t b = __builtin_convertvector(v, bf16x2_t); return __builtin_bit_cast(unsigned, b); }
__device__ __forceinline__ unsigned f2bf(float f) { return pk2(f, f) & 0xffffu; }
__device__ __forceinline__ float bf2f(unsigned short h) { return __builtin_bit_cast(float, (unsigned)h << 16); }
__device__ __forceinline__ float bflo(unsigned u) { return __builtin_bit_cast(float, u << 16); }
__device__ __forceinline__ float bfhi(unsigned u) { return __builtin_bit_cast(float, u & 0xffff0000u); }
__device__ __forceinline__ float wave_sum(float v) {
#pragma unroll
    for (int o = 1; o < 64; o <<= 1) v += __shfl_xor(v, o);
    return v;
}
__device__ __forceinline__ float sigmoidf_(float x) { return __builtin_amdgcn_rcpf(1.f + __expf(-x)); }
__device__ __forceinline__ float siluf_(float x) { return x * __builtin_amdgcn_rcpf(1.f + __expf(-x)); }
__device__ __forceinline__ float logsigf_(float z) { return fminf(z, 0.f) - __logf(1.f + __expf(-fabsf(z))); }
__device__ __forceinline__ int crow(int r, int hi) { return (r & 3) + 8 * (r >> 2) + 4 * hi; }

constexpr int DM = 2048, NB = 2, SEQ = 4096, CTXL = 256;
constexpr int ML = NB * SEQ, MC = NB * CTXL, MT = ML + MC;
constexpr int NCAT = 10496, NACT = 6144, DFF = 5632, NUP = 11264, DIN = 6176;
constexpr int NITEM1 = 2 * 8 * 2 * 68;
constexpr float EPS = 1e-6f;
constexpr float LAM_INIT = 0.2f;
constexpr int NW = 8, NT = 512;
constexpr int LDS_BYTES = 147456;

constexpr size_t MiB = 1u << 20;
constexpr size_t WS_LAM = 4096, WS_BAR = 8192, WS_TAB = 32768  , WS_MOD = 65536;
constexpr size_t WS_WPG = 277 * MiB, WS_WPD = 281 * MiB, WS_WO = 395 * MiB, WS_WDN = 1 * MiB;
constexpr size_t WS_H = 23 * MiB, WS_WCAT = 57 * MiB, WS_LR = 98 * MiB, WS_GDEC = 100 * MiB;
constexpr size_t WS_U = 23 * MiB, WS_T1 = 23 * MiB, WS_H2 = 23 * MiB, WS_WUP = 351 * MiB, WS_ACT2 = 111 * MiB;
constexpr size_t WS_ACT1 = 111 * MiB, WS_G = 213 * MiB, WS_U2 = 111 * MiB;
constexpr size_t WS_S = 287 * MiB, WS_MRG = 287 * MiB, WS_YA = 319 * MiB, WS_YB = 335 * MiB, WS_END = 403 * MiB;

struct Args { const float* in[30]; float* out; unsigned char* ws; int ph_lo, ph_hi; };

namespace epi {
using pg8::Unit; using pg8::f32x4; using pg8::u32x4; using pg8::cvt_pk_bf16; using pg8::BM; using pg8::HALF;
#define EPI_LOOP for (int ai = 0; ai < 2; ++ai) for (int m = 0; m < 4; ++m) for (int bj = 0; bj < 2; ++bj)

struct EpiP2 {
    static constexpr bool PERM = true, AFTER_DRAIN = false; static constexpr int MIDK = 0;
    bf16* ACT1; bf16* G; float* LR; const float* b_gate;
    __device__ __forceinline__ void operator()(const f32x4 (&acc)[2][2][4][2], const Unit& u, int wr, int wc, int fr, int fq) const {
        const int row0 = u.pm * BM + wr * 64 + fr, cin = wc * 32 + 8 * fq;
        if (u.pn < 24) {
            const float sc = (u.pn < 2) ? 0.125f : 1.0f;
#pragma unroll
            EPI_LOOP { const f32x4 v0 = acc[ai][bj][m][0] * sc, v1 = acc[ai][bj][m][1] * sc;
                u32x4 w; w.x = cvt_pk_bf16(v0[0], v0[1]); w.y = cvt_pk_bf16(v0[2], v0[3]); w.z = cvt_pk_bf16(v1[0], v1[1]); w.w = cvt_pk_bf16(v1[2], v1[3]);
                *(u32x4*)(ACT1 + (size_t)(row0 + ai * HALF + m * 16) * NACT + u.pn * BM + bj * HALF + cin) = w; }
        } else if (u.pn < 40) {
            if (u.pm < ML / BM) {
                const int c0 = (u.pn - 24) * BM + cin;
#pragma unroll
                EPI_LOOP { const int col = c0 + bj * HALF; const f32x4 b0 = *(const f32x4*)(b_gate + col), b1 = *(const f32x4*)(b_gate + col + 4);
                    const f32x4 v0 = acc[ai][bj][m][0] + b0, v1 = acc[ai][bj][m][1] + b1;
                    u32x4 w; w.x = cvt_pk_bf16(sigmoidf_(v0[0]), sigmoidf_(v0[1])); w.y = cvt_pk_bf16(sigmoidf_(v0[2]), sigmoidf_(v0[3]));
                    w.z = cvt_pk_bf16(sigmoidf_(v1[0]), sigmoidf_(v1[1])); w.w = cvt_pk_bf16(sigmoidf_(v1[2]), sigmoidf_(v1[3]));
                    *(u32x4*)(G + (size_t)(row0 + ai * HALF + m * 16) * 4096 + col) = w; }
            }
        } else {
            if (wc == 0) {
#pragma unroll
                for (int ai = 0; ai < 2; ++ai)
#pragma unroll
                    for (int m = 0; m < 4; ++m) { float* p = LR + (size_t)(row0 + ai * HALF + m * 16) * 32 + 8 * fq;
                        *(f32x4*)p = acc[ai][0][m][0]; *(f32x4*)(p + 4) = acc[ai][0][m][1]; }
            }
        }
    }
};
struct EpiMrg2 {
    static constexpr bool PERM = true, AFTER_DRAIN = false; static constexpr int MIDK = 16;
    const bf16* G; bf16* MRG;
    __device__ __forceinline__ void mid(f32x4 (&acc)[2][2][4][2], const Unit& u, int wr, int wc, int fr, int fq) const {
        int row0 = u.pm * BM + wr * 64 + fr, c0 = u.pn * BM + wc * 32 + 8 * fq;
        asm volatile("" : "+v"(row0), "+v"(c0));
#pragma unroll
        EPI_LOOP { const int row = row0 + ai * HALF + m * 16, col = c0 + bj * HALF;
            const bf16* gp = G + (size_t)row * 4096 + col; const u32x4 ga = *(const u32x4*)gp, gb = *(const u32x4*)(gp + 2048);
            f32x4 v0 = acc[ai][bj][m][0], v1 = acc[ai][bj][m][1];
#define RC_(x) __builtin_amdgcn_rcpf(x)
            v0[0] *= bflo(ga.x) * RC_(bflo(gb.x)); v0[1] *= bfhi(ga.x) * RC_(bfhi(gb.x)); v0[2] *= bflo(ga.y) * RC_(bflo(gb.y)); v0[3] *= bfhi(ga.y) * RC_(bfhi(gb.y));
            v1[0] *= bflo(ga.z) * RC_(bflo(gb.z)); v1[1] *= bfhi(ga.z) * RC_(bfhi(gb.z)); v1[2] *= bflo(ga.w) * RC_(bflo(gb.w)); v1[3] *= bfhi(ga.w) * RC_(bfhi(gb.w));
#undef RC_
            acc[ai][bj][m][0] = v0; acc[ai][bj][m][1] = v1; __builtin_amdgcn_sched_barrier(0); }
    }
    __device__ __forceinline__ void operator()(const f32x4 (&acc)[2][2][4][2], const Unit& u, int wr, int wc, int fr, int fq) const {
        const int row0 = u.pm * BM + wr * 64 + fr, c0 = u.pn * BM + wc * 32 + 8 * fq;
#pragma unroll
        EPI_LOOP { const int row = row0 + ai * HALF + m * 16, col = c0 + bj * HALF;
            const u32x4 g = *(const u32x4*)(G + (size_t)row * 4096 + 2048 + col);
            const f32x4 a0 = acc[ai][bj][m][0], a1 = acc[ai][bj][m][1];
            u32x4 w; w.x = cvt_pk_bf16(a0[0] * bflo(g.x), a0[1] * bfhi(g.x)); w.y = cvt_pk_bf16(a0[2] * bflo(g.y), a0[3] * bfhi(g.y));
            w.z = cvt_pk_bf16(a1[0] * bflo(g.z), a1[1] * bfhi(g.z)); w.w = cvt_pk_bf16(a1[2] * bflo(g.w), a1[3] * bfhi(g.w));
            *(u32x4*)(MRG + (size_t)row * DM + col) = w; }
    }
};
struct EpiRes {
    static constexpr bool PERM = true, AFTER_DRAIN = false; static constexpr int MIDK = 0;
    const float* base; float* out; const float* gate;
    __device__ __forceinline__ void operator()(const f32x4 (&acc)[2][2][4][2], const Unit& u, int wr, int wc, int fr, int fq) const {
        const int row0 = u.pm * BM + wr * 64 + fr, c0 = u.pn * BM + wc * 32 + 8 * fq;
        const float* gb = gate + (size_t)((u.pm * BM) / SEQ) * 12288;
#pragma unroll
        EPI_LOOP { const int row = row0 + ai * HALF + m * 16, col = c0 + bj * HALF;
            const f32x4 g0 = *(const f32x4*)(gb + col), g1 = *(const f32x4*)(gb + col + 4);
            const float* bp = base + (size_t)row * DM + col; const f32x4 x0 = *(const f32x4*)bp, x1 = *(const f32x4*)(bp + 4);
            float* p = out + (size_t)row * DM + col; *(f32x4*)p = x0 + g0 * acc[ai][bj][m][0]; *(f32x4*)(p + 4) = x1 + g1 * acc[ai][bj][m][1]; }
    }
};
struct EpiPlain {
    static constexpr bool PERM = true, AFTER_DRAIN = false; static constexpr int MIDK = 0;
    bf16* O; int ldc;
    __device__ __forceinline__ void operator()(const f32x4 (&acc)[2][2][4][2], const Unit& u, int wr, int wc, int fr, int fq) const {
        const int row0 = u.pm * BM + wr * 64 + fr, c0 = u.pn * BM + wc * 32 + 8 * fq;
#pragma unroll
        EPI_LOOP { const f32x4 v0 = acc[ai][bj][m][0], v1 = acc[ai][bj][m][1];
            u32x4 w; w.x = cvt_pk_bf16(v0[0], v0[1]); w.y = cvt_pk_bf16(v0[2], v0[3]); w.z = cvt_pk_bf16(v1[0], v1[1]); w.w = cvt_pk_bf16(v1[2], v1[3]);
            *(u32x4*)(O + (size_t)(row0 + ai * HALF + m * 16) * ldc + c0 + bj * HALF) = w; }
    }
};
struct EpiConv {
    static constexpr bool PERM = true, AFTER_DRAIN = false; static constexpr int MIDK = 0;
    bf16* ACT2; const float* conv_w; const float* conv_b; __attribute__((address_space(3))) unsigned* halo;
    __device__ __forceinline__ void operator()(const f32x4 (&acc)[2][2][4][2], const Unit& u, int wr, int wc, int fr, int fq) const {
        unsigned P[2][4][8];
#pragma unroll
        for (int ai = 0; ai < 2; ++ai)
#pragma unroll
            for (int m = 0; m < 4; ++m)
#pragma unroll
                for (int bj = 0; bj < 2; ++bj) { const f32x4 v0 = acc[ai][bj][m][0], v1 = acc[ai][bj][m][1];
                    P[ai][m][4 * bj + 0] = cvt_pk_bf16(v0[0], v0[1]); P[ai][m][4 * bj + 1] = cvt_pk_bf16(v0[2], v0[3]);
                    P[ai][m][4 * bj + 2] = cvt_pk_bf16(v1[0], v1[1]); P[ai][m][4 * bj + 3] = cvt_pk_bf16(v1[2], v1[3]); }
#pragma unroll
        for (int ai = 0; ai < 2; ++ai) { const int rb = 2 * ai + wr;
            if (fr == 0) { __attribute__((address_space(3))) unsigned* hp = halo + (((rb * 2 + 0) * 4 + wc) * 4 + fq) * 8;
#pragma unroll
                for (int e = 0; e < 8; ++e) hp[e] = P[ai][0][e]; }
            if (fr == 15) { __attribute__((address_space(3))) unsigned* hp = halo + (((rb * 2 + 1) * 4 + wc) * 4 + fq) * 8;
#pragma unroll
                for (int e = 0; e < 8; ++e) hp[e] = P[ai][3][e]; } }
        asm volatile("s_waitcnt lgkmcnt(0)" ::: "memory");
        __builtin_amdgcn_s_barrier();
        asm volatile("" ::: "memory");
        const int c8 = u.pn * 128 + wc * 32 + 8 * fq;
        float wg[3][8], wv[3][8], bg[8], bv[8];
#pragma unroll
        for (int j = 0; j < 3; ++j) { const float* cw = conv_w + (size_t)j * NUP + c8;
            const f32x4 a0 = *(const f32x4*)cw, a1 = *(const f32x4*)(cw + 4), b0 = *(const f32x4*)(cw + DFF), b1 = *(const f32x4*)(cw + DFF + 4);
            wg[j][0] = a0[0]; wg[j][1] = a0[1]; wg[j][2] = a0[2]; wg[j][3] = a0[3]; wg[j][4] = a1[0]; wg[j][5] = a1[1]; wg[j][6] = a1[2]; wg[j][7] = a1[3];
            wv[j][0] = b0[0]; wv[j][1] = b0[1]; wv[j][2] = b0[2]; wv[j][3] = b0[3]; wv[j][4] = b1[0]; wv[j][5] = b1[1]; wv[j][6] = b1[2]; wv[j][7] = b1[3]; }
        { const f32x4 a0 = *(const f32x4*)(conv_b + c8), a1 = *(const f32x4*)(conv_b + c8 + 4), b0 = *(const f32x4*)(conv_b + DFF + c8), b1 = *(const f32x4*)(conv_b + DFF + c8 + 4);
          bg[0] = a0[0]; bg[1] = a0[1]; bg[2] = a0[2]; bg[3] = a0[3]; bg[4] = a1[0]; bg[5] = a1[1]; bg[6] = a1[2]; bg[7] = a1[3];
          bv[0] = b0[0]; bv[1] = b0[1]; bv[2] = b0[2]; bv[3] = b0[3]; bv[4] = b1[0]; bv[5] = b1[1]; bv[6] = b1[2]; bv[7] = b1[3]; }
        const int kt = u.pm % 17, bb = u.pm / 17;
#pragma unroll
        for (int ai = 0; ai < 2; ++ai) { const int rb = 2 * ai + wr;
#pragma unroll
            for (int m = 0; m < 4; ++m) {
                const int i = 128 * ai + 64 * wr + 16 * m + fr, t = 254 * kt + i - 1;
                unsigned up[8], dn[8];
#pragma unroll
                for (int e = 0; e < 8; ++e) {
                    const unsigned su = (fr == 15) ? P[ai][m > 0 ? m - 1 : 0][e] : P[ai][m][e];
                    const unsigned sd = (fr == 0) ? P[ai][m < 3 ? m + 1 : 3][e] : P[ai][m][e];
                    up[e] = (unsigned)__builtin_amdgcn_update_dpp(0, (int)su, 0x121, 0xf, 0xf, false);
                    dn[e] = (unsigned)__builtin_amdgcn_update_dpp(0, (int)sd, 0x12F, 0xf, 0xf, false);
                }
                if (m == 0 && fr == 0 && rb > 0) { const __attribute__((address_space(3))) unsigned* hp = halo + ((((rb - 1) * 2 + 1) * 4 + wc) * 4 + fq) * 8;
#pragma unroll
                    for (int e = 0; e < 8; ++e) up[e] = hp[e]; }
                if (m == 3 && fr == 15 && rb < 3) { const __attribute__((address_space(3))) unsigned* hp = halo + ((((rb + 1) * 2 + 0) * 4 + wc) * 4 + fq) * 8;
#pragma unroll
                    for (int e = 0; e < 8; ++e) dn[e] = hp[e]; }
                if (t == 0) {
#pragma unroll
                    for (int e = 0; e < 8; ++e) up[e] = 0u; }
                if (t == SEQ - 1) {
#pragma unroll
                    for (int e = 0; e < 8; ++e) dn[e] = 0u; }
                float o[8];
#pragma unroll
                for (int e2 = 0; e2 < 4; ++e2) {
                    const float g0 = bg[2 * e2] + wg[0][2 * e2] * bflo(up[e2]) + wg[1][2 * e2] * bflo(P[ai][m][e2]) + wg[2][2 * e2] * bflo(dn[e2]);
                    const float g1 = bg[2 * e2 + 1] + wg[0][2 * e2 + 1] * bfhi(up[e2]) + wg[1][2 * e2 + 1] * bfhi(P[ai][m][e2]) + wg[2][2 * e2 + 1] * bfhi(dn[e2]);
                    const float v0 = bv[2 * e2] + wv[0][2 * e2] * bflo(up[4 + e2]) + wv[1][2 * e2] * bflo(P[ai][m][4 + e2]) + wv[2][2 * e2] * bflo(dn[4 + e2]);
                    const float v1 = bv[2 * e2 + 1] + wv[0][2 * e2 + 1] * bfhi(up[4 + e2]) + wv[1][2 * e2 + 1] * bfhi(P[ai][m][4 + e2]) + wv[2][2 * e2 + 1] * bfhi(dn[4 + e2]);
                    o[2 * e2] = siluf_(g0) * v0; o[2 * e2 + 1] = siluf_(g1) * v1;
                }
                if (i >= 1 && i <= 254 && t < SEQ) {
                    u32x4 w; w.x = cvt_pk_bf16(o[0], o[1]); w.y = cvt_pk_bf16(o[2], o[3]); w.z = cvt_pk_bf16(o[4], o[5]); w.w = cvt_pk_bf16(o[6], o[7]);
                    *(u32x4*)(ACT2 + (size_t)(bb * SEQ + t) * DFF + c8) = w; }
            } }
    }
};
}

__device__ __forceinline__ void tr_item(const float* W, int ld, int k0, int col0, bf16* WT, int K, int row0, LAS float* scr, int lane, int dko = 0) {
#pragma unroll 8
    for (int i = 0; i < 32; ++i) { const int kk = 2 * i + (lane >> 5); scr[kk * 33 + (lane & 31)] = W[(size_t)(k0 + kk) * ld + col0 + (lane & 31)]; }
    LDS_WAIT(); asm volatile("" ::: "memory");
    const int c = lane & 7;
#pragma unroll
    for (int j = 0; j < 4; ++j) { const int n = (lane >> 3) + 8 * j; const LAS float* s = scr + (8 * c) * 33 + n;
        v4u o; o.x = pk2(s[0 * 33], s[1 * 33]); o.y = pk2(s[2 * 33], s[3 * 33]); o.z = pk2(s[4 * 33], s[5 * 33]); o.w = pk2(s[6 * 33], s[7 * 33]);
        *(v4u*)(WT + (size_t)(row0 + n) * K + dko + k0 + 8 * c) = o; }
    LDS_WAIT(); asm volatile("" ::: "memory");
}
#define TRJOB2(SRC, LD, KSRC, COL0, DST, KPITCH, DKO, ROW0, NCOLS) { const int nb_ = (NCOLS) / 32, ni_ = ((KSRC) / 64) * nb_; \
    if (r < ni_) { const int kb_ = r / nb_, nn_ = r % nb_; tr_item((SRC), (LD), 64 * kb_, (COL0) + 32 * nn_, (DST), (KPITCH), (ROW0) + 32 * nn_, scr, lane, (DKO)); continue; } r -= ni_; }
#define TRJOB(SRC, LD, KK, COL0, DST, ROW0, NCOLS) { const int nb_ = (NCOLS) / 32, ni_ = ((KK) / 64) * nb_; \
    if (r < ni_) { const int kb_ = r / nb_, nn_ = r % nb_; tr_item((SRC), (LD), 64 * kb_, (COL0) + 32 * nn_, (DST), (KK), (ROW0) + 32 * nn_, scr, lane); continue; } r -= ni_; }

__device__ __forceinline__ void norm_mod_row2(const float* xa, const float* xb, bool hasb, const float* nw, const float* mva, const float* mvb, int shoff, bf16* oa, bf16* ob, int lane) {
    const f32x4* xra = (const f32x4*)xa + lane; const f32x4* xrb = (const f32x4*)(hasb ? xb : xa) + lane;
    f32x4 va[8], vb[8]; float sa = 0.f, sb = 0.f;
#pragma unroll
    for (int j = 0; j < 8; ++j) { va[j] = xra[64 * j]; vb[j] = xrb[64 * j]; }
#pragma unroll
    for (int j = 0; j < 8; ++j) { sa += (va[j].x * va[j].x + va[j].y * va[j].y) + (va[j].z * va[j].z + va[j].w * va[j].w); sb += (vb[j].x * vb[j].x + vb[j].y * vb[j].y) + (vb[j].z * vb[j].z + vb[j].w * vb[j].w); }
    const float ra = rsqrtf(wave_sum(sa) * (1.f / DM) + EPS), rb = rsqrtf(wave_sum(sb) * (1.f / DM) + EPS);
#pragma unroll
    for (int j = 0; j < 8; ++j) { const int idx = 4 * (lane + 64 * j);
        const f32x4 w = *(const f32x4*)(nw + idx);
        { const f32x4 sh = *(const f32x4*)(mva + shoff + idx), sc = *(const f32x4*)(mva + shoff + DM + idx);
          const f32x4 y = (va[j] * ra * w) * (sc + 1.0f) + sh; v2u o; o.x = pk2(y.x, y.y); o.y = pk2(y.z, y.w); *(v2u*)(oa + idx) = o; }
        if (hasb) { const f32x4 sh = *(const f32x4*)(mvb + shoff + idx), sc = *(const f32x4*)(mvb + shoff + DM + idx);
          const f32x4 y = (vb[j] * rb * w) * (sc + 1.0f) + sh; v2u o; o.x = pk2(y.x, y.y); o.y = pk2(y.z, y.w); *(v2u*)(ob + idx) = o; } }
}

#define XB_TMO      128
#define XB_XCNT(j)  (256  + 64 * (j))
#define XB_XSUB(j)  (1280 + 64 * (j))
#define XB_XGEN(j)  (2304 + 64 * (j))
#define XB_TOP      3328
#define XB_TOPGEN   3392
#define XCD_BAR_WORDS 3456
#define XB_SPIN_CAP (1u << 18)

__device__ __forceinline__ unsigned xb_ld(unsigned* p)              { return __hip_atomic_load(p, __ATOMIC_RELAXED, __HIP_MEMORY_SCOPE_AGENT); }
__device__ __forceinline__ unsigned xb_add(unsigned* p, unsigned v) { return __hip_atomic_fetch_add(p, v, __ATOMIC_RELAXED, __HIP_MEMORY_SCOPE_AGENT); }
__device__ __forceinline__ unsigned xb_xcc_id() { return (unsigned)__builtin_amdgcn_s_getreg((3 << 11) | 20) & 0xFu; }
#define XB_SPIN(cond, bar) do { unsigned _sp = 0; while (cond) { __builtin_amdgcn_s_sleep(1); \
    if ((++_sp & 255u) == 0u) { if (xb_ld(&(bar)[XB_TMO])) break; if (_sp > XB_SPIN_CAP) { atomicAdd(&(bar)[XB_TMO], 1u); break; } } } } while (0)

struct XcdBarrier {
    unsigned* bar; unsigned x;
    volatile LAS unsigned* st;
};

__device__ __forceinline__ XcdBarrier xcd_barrier_post(unsigned* bar, volatile LAS unsigned* st) {
    XcdBarrier b; b.bar = bar; b.x = xb_xcc_id(); b.st = st;
    if (threadIdx.x == 0) (void)xb_add(&bar[XB_XCNT(b.x)], 1u);
    return b;
}
__device__ __forceinline__ void xcd_barrier_complete(unsigned* bar, unsigned x, unsigned& nloc, unsigned& nx) {
    const unsigned G = gridDim.x * gridDim.y * gridDim.z;
    unsigned sum, cnt, mine, sp = 0u;
    for (;;) {
        sum = 0u; cnt = 0u; mine = 0u;
#pragma unroll
        for (unsigned j = 0; j < 16; ++j) { const unsigned c = xb_ld(&bar[XB_XCNT(j)]); sum += c; cnt += (c > 0u) ? 1u : 0u; mine = (j == x) ? c : mine; }
        if (sum == G) break;
        __builtin_amdgcn_s_sleep(1);
        if ((++sp & 255u) == 0u) { if (xb_ld(&bar[XB_TMO])) break; if (sp > XB_SPIN_CAP) { atomicAdd(&bar[XB_TMO], 1u); break; } }
    }
    nloc = mine > 0u ? mine : 1u; nx = cnt > 0u ? cnt : 1u;
}

__device__ __forceinline__ void xcd_barrier(const XcdBarrier& b) {
    asm volatile("s_waitcnt vmcnt(0)" ::: "memory");
    __syncthreads();
    if (threadIdx.x == 0) {
        unsigned* bar = b.bar;
        __builtin_amdgcn_s_waitcnt(0);
        unsigned nloc = b.st[0], nx = b.st[1];
        if (nloc == 0u) { xcd_barrier_complete(bar, b.x, nloc, nx); b.st[0] = nloc; b.st[1] = nx; }
        const unsigned old = xb_add(&bar[XB_XSUB(b.x)], 1u);
        const unsigned gen = old / nloc;
        if (old + 1u == (gen + 1u) * nloc) {
            __builtin_amdgcn_fence(__ATOMIC_RELEASE, "agent");
            asm volatile("s_waitcnt vmcnt(0)" ::: "memory");
            const unsigned og = xb_add(&bar[XB_TOP], 1u);
            const unsigned tg = og / nx;
            if (og + 1u == (tg + 1u) * nx) xb_add(&bar[XB_TOPGEN], 1u);
            else XB_SPIN(xb_ld(&bar[XB_TOPGEN]) == tg, bar);
            __builtin_amdgcn_fence(__ATOMIC_ACQUIRE, "agent");
            xb_add(&bar[XB_XGEN(b.x)], 1u);
            asm volatile("s_waitcnt vmcnt(0)" ::: "memory");
        } else {
            XB_SPIN(xb_ld(&bar[XB_XGEN(b.x)]) == gen, bar);
            __builtin_amdgcn_fence(__ATOMIC_ACQUIRE, "agent");
            asm volatile("s_waitcnt vmcnt(0)" ::: "memory");
        }
    }
    __syncthreads();
}

__global__ void __launch_bounds__(NT, 2) mega_fwd(Args args) {
    extern __shared__ __attribute__((aligned(16))) unsigned char lds_raw[];
    LAS unsigned char* lds = (LAS unsigned char*)lds_raw;
    cg::grid_group grid = cg::this_grid();
    const int tid = threadIdx.x, lane = tid & 63, wave = __builtin_amdgcn_readfirstlane(tid >> 6);
    const int G_ = gridDim.x, bid = blockIdx.x;
    const int gw = bid * NW + wave, NGW = G_ * NW;
    const int lo = args.ph_lo, hi = args.ph_hi;
    const bool multi = (hi - lo) > 1;
    unsigned char* ws = args.ws;
    volatile LAS unsigned* xst = (volatile LAS unsigned*)(lds + LDS_BYTES - 16);
    if (tid < 4) xst[tid] = 0u;
    __syncthreads();
    XcdBarrier xb; xb.bar = (unsigned*)(ws + WS_BAR); xb.x = 0; xb.st = xst;
    if (multi && bid == 0) { unsigned* bw = (unsigned*)(ws + WS_BAR); for (int i = tid; i < XCD_BAR_WORDS; i += NT) bw[i] = 0u; }
#ifndef MK_RPT
#define MK_RPT 0
#endif
#define RPT(k) ((MK_RPT >> (k)) & 1)
#define IN(k) (lo <= (k) && (k) < hi)
#define SEAM(k) do { if (multi && IN((k) + 1)) { if ((k) == 0) { grid.sync(); xb = xcd_barrier_post((unsigned*)(ws + WS_BAR), xst); } else xcd_barrier(xb); } } while (0)

    const float* x = args.in[0]; const float* cvec = args.in[1]; const float* ctx = args.in[2]; const float* c_ctx = args.in[3];
    const float* w_ada = args.in[4]; const float* b_ada = args.in[5]; const float* norm1_w = args.in[6]; const float* w_in = args.in[7];
    const float* w_a_up_f = args.in[8]; const float* b_a_f = args.in[9]; const float* w_a_up_b = args.in[10]; const float* b_a_b = args.in[11];
    const float* gla_onorm_w = args.in[12]; const float* qnorm_w = args.in[13]; const float* knorm_w = args.in[14];
    const float* diff_onorm_w = args.in[19]; const float* w_proj_gla = args.in[20]; const float* w_proj_diff = args.in[21];
    const float* w_gate = args.in[22]; const float* b_gate = args.in[23]; const float* w_out = args.in[24]; const float* norm2_w = args.in[25];
    const float* w_up = args.in[26]; const float* conv_w = args.in[27]; const float* conv_b = args.in[28]; const float* w_down = args.in[29];
    float* out = args.out;
    float* MOD = (float*)(ws + WS_MOD); float* LAMP = (float*)(ws + WS_LAM);
    bf16* WCAT = (bf16*)(ws + WS_WCAT); bf16* WPG = (bf16*)(ws + WS_WPG); bf16* WPD = (bf16*)(ws + WS_WPD); bf16* WO = (bf16*)(ws + WS_WO);
    bf16* WUP = (bf16*)(ws + WS_WUP); bf16* WDN = (bf16*)(ws + WS_WDN);
    bf16* H = (bf16*)(ws + WS_H); bf16* H2 = (bf16*)(ws + WS_H2); bf16* ACT1 = (bf16*)(ws + WS_ACT1); bf16* GB = (bf16*)(ws + WS_G);
    float* LR = (float*)(ws + WS_LR); float* GDEC = (float*)(ws + WS_GDEC); float* UB = (float*)(ws + WS_U); bf16* SB = (bf16*)(ws + WS_S);
    bf16* YA = (bf16*)(ws + WS_YA); bf16* YB = (bf16*)(ws + WS_YB); float* T1 = (float*)(ws + WS_T1); bf16* MRG = (bf16*)(ws + WS_MRG);
    bf16* U2 = (bf16*)(ws + WS_U2); bf16* ACT2 = (bf16*)(ws + WS_ACT2);

    if (IN(0)) { for (int rep_ = 0; rep_ <= RPT(0); ++rep_) {
        {
            LAS float* sc = (LAS float*)lds; LAS float* red = sc + 3 * DM;
            for (int i = tid; i < 3 * DM; i += NT) { const int v = i / DM, k = i % DM; const float s = v < 2 ? cvec[v * DM + k] : c_ctx[k]; sc[i] = siluf_(s); }
            __syncthreads();
            const int cl = tid % 12, rl = tid / 12;
            for (int cb = bid; cb < 256; cb += G_) {
                f32x4 a0 = {0.f, 0.f, 0.f, 0.f}, a1 = a0, a2 = a0;
                if (tid < 504) {
                    const float* wp = w_ada + 48 * cb + 4 * cl;
                    for (int k = rl; k < DM; k += 42) { const f32x4 w = *(const f32x4*)(wp + (size_t)k * 12288); a0 += w * sc[k]; a1 += w * sc[DM + k]; a2 += w * sc[2 * DM + k]; }
                    LAS float* rp = red + (rl * 12 + cl) * 12;
#pragma unroll
                    for (int e = 0; e < 4; ++e) { rp[e] = a0[e]; rp[4 + e] = a1[e]; rp[8 + e] = a2[e]; }
                }
                __syncthreads();
                if (tid < 144) { const int cl2 = tid / 12, ve = tid % 12, v = ve >> 2, e = ve & 3; float s = 0.f;
                    for (int r2 = 0; r2 < 42; ++r2) s += red[(r2 * 12 + cl2) * 12 + ve];
                    const int n = 48 * cb + 4 * cl2 + e; MOD[v * 12288 + n] = s + b_ada[n]; }
                __syncthreads();
            }
            if (bid == 1 % G_) { float* tabg = (float*)(ws + WS_TAB);
                for (int i = tid; i < 1024; i += NT) { const int pos_ = i >> 4, f = i & 15;
                    const float invf = exp2f(-(float)f * (13.287712379549449f / 16.f));
                    float sn, cs; sincosf((float)pos_ * invf, &sn, &cs); tabg[2 * i] = cs; tabg[2 * i + 1] = sn; } }
            if (bid == 0 && tid == 0) { float s1 = 0.f, s2 = 0.f;
                for (int i = 0; i < 64; ++i) { s1 += args.in[15][i] * args.in[16][i]; s2 += args.in[17][i] * args.in[18][i]; }
                LAMP[0] = expf(s1) - expf(s2) + LAM_INIT; }
        }
        {
            LAS float* scr = (LAS float*)(lds + wave * 16384);
            constexpr int NITEMS = 2 * 32 * 96 + 32 * 128 + 32 * 1 + 2 * 16 * 64 + 32 * 64;
            for (int it = gw; it < NITEMS; it += NGW) {
                int r = it;
                TRJOB(w_in, DIN, 2048, 0, WCAT, 0, 3072)
                TRJOB(w_in, DIN, 2048, 3104, WCAT, 3072, 3072)
                TRJOB(w_gate, 4096, 2048, 0, WCAT, 6144, 4096)
                TRJOB(w_in, DIN, 2048, 3072, WCAT, 10240, 32)
                TRJOB2(w_proj_gla, 2048, 1024, 0, WPG, 2048, 0, 0, 2048)
                TRJOB2(w_proj_diff, 2048, 1024, 0, WPG, 2048, 1024, 0, 2048)
                TRJOB(w_out, 2048, 2048, 0, WO, 0, 2048)
            }
            v4u* z = (v4u*)(WCAT + (size_t)10272 * 2048);
            for (int i = bid * NT + tid; i < 224 * 2048 / 8; i += G_ * NT) z[i] = (v4u){0u, 0u, 0u, 0u};
        }
        __syncthreads(); }
        SEAM(0);
    }

    if (IN(1)) { for (int rep_ = 0; rep_ <= RPT(1); ++rep_) {
        for (int r = gw; r < MT; r += 2 * NGW) {
            const int r2 = r + NGW; const bool hb = r2 < MT; const int rb = hb ? r2 : r;
            const float* sa = r < ML ? x + (size_t)r * DM : ctx + (size_t)(r - ML) * DM;
            const float* sb = rb < ML ? x + (size_t)rb * DM : ctx + (size_t)(rb - ML) * DM;
            norm_mod_row2(sa, sb, hb, norm1_w, MOD + (size_t)(r < ML ? r / SEQ : 2) * 12288, MOD + (size_t)(rb < ML ? rb / SEQ : 2) * 12288, 0, H + (size_t)r * DM, H + (size_t)rb * DM, lane);
        }
        __syncthreads(); }
        SEAM(1);
    }

    if (IN(2)) { for (int rep_ = 0; rep_ <= RPT(2); ++rep_) {
        pg8::Gemm g{H, WCAT, MT, NCAT, DM}; pg8::StaticOrder S; S.init(MT, NCAT, G_, bid);
        epi::EpiP2 E{ACT1, GB, LR, b_gate};
        pg8::gemm_phase<epi::EpiP2, pg8::StaticOrder, true, true>(lds, g, S, E);
        {
            const int nun = (MT / 256) * (NCAT / 256), rounds = (nun + G_ - 1) / G_, nlast = nun - (rounds - 1) * G_;
            int nidle = G_ - nlast, j = bid - nlast;
            if (nidle == 0) { nidle = G_; j = bid; }
            if (j >= 0) {
                LAS float* scr = (LAS float*)(lds + wave * 16384);
                for (int it = j * NW + wave; it < 32 * 352 + 88 * 64; it += nidle * NW) {
                    if (it < 32 * 352) { const int kb = it / 352, nb = it % 352, row0 = 32 * nb, T = row0 >> 8, rr = row0 & 255;
                        const int col0 = rr < 128 ? 128 * T + rr : DFF + 128 * T + (rr - 128);
                        tr_item(w_up, NUP, 64 * kb, col0, WUP, 2048, row0, scr, lane); }
                    else { const int r = it - 32 * 352, kb = r / 64, nb = r % 64; tr_item(w_down, 2048, 64 * kb, 32 * nb, WDN, DFF, 32 * nb, scr, lane); } }
            }
        }
        __syncthreads(); }
        SEAM(2);
    }

    if (IN(3)) { for (int rep_ = 0; rep_ <= RPT(3); ++rep_) {
        {
            const float* tab = (const float*)(ws + WS_TAB);
            const int nheavy = (NITEM1 > NGW && NITEM1 - NGW < NGW) ? NITEM1 - NGW : 0;
            const int rw = gw - nheavy, nrw = NGW - nheavy;
            const int l8 = lane & 7;
            const bool lower = ((l8 >> 1) & 1) == 0;
            if (rw >= 0) for (int wi0 = rw; wi0 < MT * 4; wi0 += 2 * nrw) {
                v4u raw[2]; bool ok[2]; bf16* ptr[2];
#pragma unroll
                for (int u = 0; u < 2; ++u) { const int wi = wi0 + u * nrw, r = wi >> 2, gi = 8 * (wi & 3) + (lane >> 3);
                    ok[u] = (wi < MT * 4) && !(r >= ML && gi < 16);
                    ptr[u] = ACT1 + (size_t)(ok[u] ? r : 0) * NACT + 3072 + 64 * gi + 8 * l8;
                    raw[u] = ok[u] ? *(const v4u*)ptr[u] : (v4u){0u, 0u, 0u, 0u}; }
#pragma unroll
                for (int u = 0; u < 2; ++u) {
                    if (!ok[u]) continue;
                    const int wi = wi0 + u * nrw, r = wi >> 2, gi = 8 * (wi & 3) + (lane >> 3);
                    const bool isq = gi < 16;
                    float y[8] = {bflo(raw[u].x), bfhi(raw[u].x), bflo(raw[u].y), bfhi(raw[u].y), bflo(raw[u].z), bfhi(raw[u].z), bflo(raw[u].w), bfhi(raw[u].w)};
                    float ss = 0.f;
#pragma unroll
                    for (int e = 0; e < 8; ++e) ss += y[e] * y[e];
                    ss += __shfl_xor(ss, 1); ss += __shfl_xor(ss, 2); ss += __shfl_xor(ss, 4);
                    const float rs = rsqrtf(ss * (1.f / 64.f) + EPS);
                    const float* nwp = (isq ? qnorm_w : knorm_w) + 8 * l8;
#pragma unroll
                    for (int e = 0; e < 8; ++e) y[e] = y[e] * rs * nwp[e];
                    if (r < ML) {
                        const int t = r & (SEQ - 1); const int pos_ = (l8 < 4) ? (t >> 6) : (t & 63);
                        const float qs = isq ? 0.125f * 1.4426950408889634f : 1.0f;
                        const float* tp = tab + 2 * (pos_ * 16 + 8 * (l8 & 1));
#pragma unroll
                        for (int e = 0; e < 8; ++e) {
                            const float yp = __shfl_xor(y[e], 2);
                            const float cs = tp[2 * e], sn = tp[2 * e + 1];
                            y[e] = (lower ? (y[e] * cs - yp * sn) : (y[e] * cs + yp * sn)) * qs;
                        }
                    }
                    v4u o; o.x = pk2(y[0], y[1]); o.y = pk2(y[2], y[3]); o.z = pk2(y[4], y[5]); o.w = pk2(y[6], y[7]);
                    *(v4u*)ptr[u] = o;
                }
            }
        }
        {
            LAS unsigned char* wl = lds + wave * 18176;
            LAS float* tot = (LAS float*)(wl + 17920);
            const int l31 = lane & 31, hh = lane >> 5, qq = (lane & 15) >> 2, pp = lane & 3, blk = (lane >> 4) & 1;
            for (int item = gw; item < NITEM1; item += NGW) {
                const int c = item % 68, chain = item / 68, dir = chain & 1, bh = chain >> 1, h = bh & 7, b = bh >> 3;
                const int R0 = (c < 4) ? ML + 256 * b + (dir ? 192 - 64 * c : 64 * c) : SEQ * b + (dir ? SEQ - 64 * (c - 3) : 64 * (c - 4));
                const float* wup = (dir ? w_a_up_b : w_a_up_f) + 64 * h + lane;
                const float bias = (dir ? b_a_b : b_a_f)[64 * h + lane];
                int lri[16];
#pragma unroll
                for (int q4 = 0; q4 < 4; ++q4) { const f32x4 t_ = *(const f32x4*)(LR + (size_t)(R0 + lane) * 32 + 16 * dir + 4 * q4);
                    lri[4 * q4] = __float_as_int(t_.x); lri[4 * q4 + 1] = __float_as_int(t_.y); lri[4 * q4 + 2] = __float_as_int(t_.z); lri[4 * q4 + 3] = __float_as_int(t_.w); }
                float wu[16];
#pragma unroll
                for (int r2 = 0; r2 < 16; ++r2) wu[r2] = wup[r2 * 512];
                { const bf16* kp = ACT1 + (size_t)(R0 + lane) * NACT + 512 + 64 * h;
#pragma unroll
                  for (int c8 = 0; c8 < 8; ++c8) *(LAS v4u*)(wl + lane * 144 + 16 * c8) = *(const v4u*)(kp + 8 * c8); }
                LDS_WAIT(); asm volatile("" ::: "memory");
                float bsum = 0.f;
                for (int p = 0; p < 64; ++p) {
                    const int rho = dir ? 63 - p : p;
                    float z = bias;
#pragma unroll
                    for (int r2 = 0; r2 < 16; ++r2) z += __int_as_float(__builtin_amdgcn_readlane(lri[r2], rho)) * wu[r2];
                    bsum += logsigf_(z) * (1.f / 16.f);
                    LAS bf16* kq = (LAS bf16*)(wl + rho * 144) + lane;
                    *kq = (bf16)f2bf(bf2f(*kq) * __expf(-bsum));
                }
                const float et = __expf(bsum);
                tot[lane] = et; GDEC[(size_t)item * 64 + lane] = et;
#pragma unroll 1
                for (int eh = 0; eh < 2; ++eh) {
                    { const bf16* vp = ACT1 + (size_t)R0 * NACT + 1024 + 128 * h + 64 * eh;
#pragma unroll
                      for (int k2 = 0; k2 < 8; ++k2) { const int idx = lane + 64 * k2, row = idx >> 3, c8 = idx & 7;
                        const v4u t = *(const v4u*)(vp + (size_t)row * NACT + 8 * c8);
                        LAS unsigned char* dp = wl + 9216 + row * 136 + 16 * c8; *(LAS v2u*)dp = (v2u){t.x, t.y}; *(LAS v2u*)(dp + 8) = (v2u){t.z, t.w}; } }
                    LDS_WAIT(); asm volatile("" ::: "memory");
#pragma unroll
                    for (int db = 0; db < 2; ++db)
#pragma unroll
                        for (int eb = 0; eb < 2; ++eb) {
                            f32x16 acc;
#pragma unroll
                            for (int i = 0; i < 16; ++i) acc[i] = 0.f;
#pragma unroll
                            for (int s = 0; s < 4; ++s) {
                                const LAS unsigned char* ap = wl + (16 * s + 4 * hh + qq) * 144 + 64 * db + 32 * blk + 8 * pp;
                                const LAS unsigned char* bp = wl + 9216 + (16 * s + 4 * hh + qq) * 136 + 64 * eb + 32 * blk + 8 * pp;
                                const s16x4 alo = __builtin_bit_cast(s16x4, __builtin_amdgcn_ds_read_tr16_b64_v4i16((LAS v4i16_t*)ap));
                                const s16x4 ahi = __builtin_bit_cast(s16x4, __builtin_amdgcn_ds_read_tr16_b64_v4i16((LAS v4i16_t*)(ap + 8 * 144)));
                                const s16x4 blo = __builtin_bit_cast(s16x4, __builtin_amdgcn_ds_read_tr16_b64_v4i16((LAS v4i16_t*)bp));
                                const s16x4 bhi = __builtin_bit_cast(s16x4, __builtin_amdgcn_ds_read_tr16_b64_v4i16((LAS v4i16_t*)(bp + 8 * 136)));
                                acc = MFMA32(__builtin_shufflevector(alo, ahi, 0, 1, 2, 3, 4, 5, 6, 7), __builtin_shufflevector(blo, bhi, 0, 1, 2, 3, 4, 5, 6, 7), acc);
                            }
                            float* up = UB + (size_t)item * 8192 + (size_t)(64 * eh + 32 * eb + l31) * 64 + 32 * db + 4 * hh;
#pragma unroll
                            for (int g4 = 0; g4 < 4; ++g4) { const f32x4 t = *(const LAS f32x4*)(tot + 32 * db + 8 * g4 + 4 * hh);
                                *(f32x4*)(up + 8 * g4) = (f32x4){acc[4 * g4] * t.x, acc[4 * g4 + 1] * t.y, acc[4 * g4 + 2] * t.z, acc[4 * g4 + 3] * t.w}; }
                        }
                    LDS_WAIT(); asm volatile("" ::: "memory");
                }
            }
        }
        __syncthreads(); }
        SEAM(3);
    }

    if (IN(4)) { for (int rep_ = 0; rep_ <= RPT(4); ++rep_) {
        {
            typedef float f32x2_ __attribute__((ext_vector_type(2)));
            for (int ti = bid * NT + tid; ti < 131072; ti += G_ * NT) {
                const int chain = ti >> 12, el = ti & 4095, e = el >> 5, d2 = (el & 31) * 2;
                f32x2_ sv = {0.f, 0.f};
                const float* up = UB + (size_t)chain * 68 * 8192 + e * 64 + d2; const float* gp = GDEC + (size_t)chain * 68 * 64 + d2;
                bf16* sp = SB + (size_t)chain * 64 * 8192 + e * 64 + d2;
#pragma unroll 1
                for (int c0 = 0; c0 < 68; c0 += 17) {
                    f32x2_ uu[17], gg[17];
#pragma unroll
                    for (int j = 0; j < 17; ++j) { uu[j] = *(const f32x2_*)(up + (size_t)(c0 + j) * 8192); gg[j] = *(const f32x2_*)(gp + (c0 + j) * 64); }
#pragma unroll
                    for (int j = 0; j < 17; ++j) { const int c = c0 + j;
                        if (c >= 4) *(unsigned*)(sp + (size_t)(c - 4) * 8192) = pk2(sv.x, sv.y);
                        sv = gg[j] * sv + uu[j]; }
                }
            }
        }
        {
            const float lam = LAMP[0];
            float kbound; { float wmx = fabsf(knorm_w[lane]);
#pragma unroll
                for (int o = 1; o < 64; o <<= 1) wmx = fmaxf(wmx, __shfl_xor(wmx, o));
                kbound = 8.f * wmx * 1.01f; }
            const int mp = wave >> 2, qw = wave & 3, l31 = lane & 31, hh = lane >> 5;
            const int qq = (lane & 15) >> 2, pp = lane & 3, blk = (lane >> 4) & 1;
            constexpr int KP = 272, VP = 320, STG = 64 * KP + 64 * VP;
            for (int un = bid; un < 512; un += G_) {
                const int b = un >> 8, h = (un >> 5) & 7, qb = un & 31;
                const int Rq = SEQ * b + 128 * qb + 32 * qw + l31;
                bf16x8 qf[4];
#pragma unroll
                for (int ks = 0; ks < 4; ++ks) qf[ks] = *(const bf16x8*)(ACT1 + (size_t)Rq * NACT + 3072 + 128 * h + 64 * mp + 16 * ks + 8 * hh);
                f32x16 O[4];
#pragma unroll
                for (int eb = 0; eb < 4; ++eb)
#pragma unroll
                    for (int i = 0; i < 16; ++i) O[eb][i] = 0.f;
                float negm; float lsum = 0.f;
                { float qn2 = 0.f;
#pragma unroll
                  for (int ks = 0; ks < 4; ++ks)
#pragma unroll
                      for (int j = 0; j < 8; ++j) { const float qv = bf2f((unsigned short)qf[ks][j]); qn2 += qv * qv; }
                  qn2 += __shfl_xor(qn2, 32);
                  negm = -sqrtf(qn2) * kbound; }
                const int srow0 = tid >> 4, sc16 = tid & 15;
                v4u stK[2], stV[2];
#define ATT_LOAD(kt) do { const int krow0_ = (kt) < 4 ? ML + 256 * b + 64 * (kt) : SEQ * b + 64 * ((kt) - 4); \
                    _Pragma("unroll") for (int p = 0; p < 2; ++p) { const bf16* src_ = ACT1 + (size_t)(krow0_ + srow0 + 32 * p) * NACT + 128 * h + 8 * sc16; \
                        stK[p] = *(const v4u*)(src_ + 4096); stV[p] = *(const v4u*)(src_ + 5120); } } while (0)
#define ATT_STORE(stg) do { _Pragma("unroll") for (int p = 0; p < 2; ++p) { LAS unsigned char* d_ = lds + (stg) * STG + (srow0 + 32 * p) * KP + 16 * sc16; \
                        *(LAS v4u*)d_ = stK[p]; *(LAS v4u*)(lds + (stg) * STG + 64 * KP + (srow0 + 32 * p) * VP + 16 * sc16) = stV[p]; } } while (0)
                ATT_LOAD(0); ATT_STORE(0);
                __syncthreads();
                for (int kt = 0; kt < 68; ++kt) {
                    if (kt + 1 < 68) ATT_LOAD(kt + 1);
                    const LAS unsigned char* Kb = lds + (kt & 1) * STG; const LAS unsigned char* Vb = Kb + 64 * KP;
                    f32x16 X[2];
#pragma unroll
                    for (int t2 = 0; t2 < 2; ++t2) {
#pragma unroll
                        for (int i = 0; i < 16; ++i) X[t2][i] = 0.f;
#pragma unroll
                        for (int ks = 0; ks < 4; ++ks) { const bf16x8 kf = *(const LAS bf16x8*)(Kb + (32 * t2 + l31) * KP + 2 * (64 * mp + 16 * ks + 8 * hh)); X[t2] = MFMA32(kf, qf[ks], X[t2]); }
                    }
                    float ps = 0.f;
#pragma unroll
                    for (int t2 = 0; t2 < 2; ++t2)
#pragma unroll
                        for (int i = 0; i < 16; ++i) { const float p = __builtin_amdgcn_exp2f(X[t2][i] + negm); X[t2][i] = p; ps += p; }
                    lsum += ps;
#pragma unroll
                    for (int t2 = 0; t2 < 2; ++t2)
#pragma unroll
                        for (int s = 0; s < 2; ++s) {
                            v4u pk; pk.x = pk2(X[t2][8 * s + 0], X[t2][8 * s + 1]); pk.y = pk2(X[t2][8 * s + 2], X[t2][8 * s + 3]);
                            pk.z = pk2(X[t2][8 * s + 4], X[t2][8 * s + 5]); pk.w = pk2(X[t2][8 * s + 6], X[t2][8 * s + 7]);
                            const bf16x8 pf = __builtin_bit_cast(bf16x8, pk);
                            const LAS unsigned char* vrow = Vb + (32 * t2 + 16 * s + 4 * hh + qq) * VP + 32 * blk + 8 * pp;
#pragma unroll
                            for (int eb = 0; eb < 4; ++eb) {
                                const s16x4 vlo = __builtin_bit_cast(s16x4, __builtin_amdgcn_ds_read_tr16_b64_v4i16((LAS v4i16_t*)(vrow + 64 * eb)));
                                const s16x4 vhi = __builtin_bit_cast(s16x4, __builtin_amdgcn_ds_read_tr16_b64_v4i16((LAS v4i16_t*)(vrow + 8 * VP + 64 * eb)));
                                const bf16x8 vf = __builtin_shufflevector(vlo, vhi, 0, 1, 2, 3, 4, 5, 6, 7);
                                O[eb] = MFMA32(vf, pf, O[eb]);
                            }
                        }
                    if (kt + 1 < 68) ATT_STORE((kt + 1) & 1);
                    __syncthreads();
                }
#undef ATT_LOAD
#undef ATT_STORE
                lsum += __shfl_xor(lsum, 32);
                const float inv = 1.f / lsum;
                LAS float* ob = (LAS float*)lds;
                if (mp == 1) {
                    const float sc = inv * lam;
#pragma unroll
                    for (int eb = 0; eb < 4; ++eb)
#pragma unroll
                        for (int i = 0; i < 16; ++i) ob[(32 * qw + l31) * 132 + 32 * eb + crow(i, hh)] = O[eb][i] * sc;
                }
                __syncthreads();
                if (mp == 0) {
                    float ss = 0.f;
#pragma unroll
                    for (int eb = 0; eb < 4; ++eb)
#pragma unroll
                        for (int i = 0; i < 16; ++i) { const float v = O[eb][i] * inv - ob[(32 * qw + l31) * 132 + 32 * eb + crow(i, hh)]; O[eb][i] = v; ss += v * v; }
                    ss += __shfl_xor(ss, 32);
                    const float rs = rsqrtf(ss * (1.f / 128.f) + EPS) * (1.f - LAM_INIT);
                    bf16* yp = YA + (size_t)Rq * 2048 + 1024 + 128 * h;
#pragma unroll
                    for (int eb = 0; eb < 4; ++eb)
#pragma unroll
                        for (int g4 = 0; g4 < 4; ++g4) { const int e0 = 32 * eb + 8 * g4 + 4 * hh; const f32x4 w = *(const f32x4*)(diff_onorm_w + e0);
                            v2u o; o.x = pk2(O[eb][4 * g4 + 0] * rs * w.x, O[eb][4 * g4 + 1] * rs * w.y); o.y = pk2(O[eb][4 * g4 + 2] * rs * w.z, O[eb][4 * g4 + 3] * rs * w.w);
                            *(v2u*)(yp + e0) = o; }
                }
                __syncthreads();
            }
        }
        __syncthreads(); }
        SEAM(4);
    }

    if (IN(5)) { for (int rep_ = 0; rep_ <= RPT(5); ++rep_) {
        const int g = tid >> 8, gwv = wave & 3, gt = tid & 255;
        LAS unsigned char* gl = lds + g * 55808;
        LAS float* xch = (LAS float*)(gl + 53248);
        const int l31 = lane & 31, hh = lane >> 5, qq = (lane & 15) >> 2, pp = lane & 3, blk = (lane >> 4) & 1;
        const int ib = gwv & 1, eh = gwv >> 1, itok = 32 * ib + l31;
        for (int pi = bid; pi < 512; pi += G_) {
            const int item = 2 * pi + g, m = item & 63, bh = item >> 6, h = bh & 7, b = bh >> 3, R0 = SEQ * b + 64 * m;
            bf16x8 Sfr[2][8]; v2u rr[2][4];
#pragma unroll
            for (int eb = 0; eb < 2; ++eb) {
#pragma unroll
                for (int ks = 0; ks < 8; ++ks) { const int dir = ks >> 2;
                    Sfr[eb][ks] = *(const bf16x8*)(SB + ((size_t)(bh * 2 + dir) * 64 + (dir ? 63 - m : m)) * 8192 + (size_t)(64 * eh + 32 * eb + l31) * 64 + 16 * (ks & 3) + 8 * hh); }
#pragma unroll
                for (int g4 = 0; g4 < 4; ++g4) rr[eb][g4] = *(const v2u*)(ACT1 + (size_t)(R0 + itok) * NACT + 2048 + 128 * h + 64 * eh + 32 * eb + 8 * g4 + 4 * hh);
            }
            {
                const int rw0 = 16 * gwv;
                float wuf[16], wub[16];
#pragma unroll
                for (int r2 = 0; r2 < 16; ++r2) { wuf[r2] = w_a_up_f[r2 * 512 + 64 * h + lane]; wub[r2] = w_a_up_b[r2 * 512 + 64 * h + lane]; }
                const float biasf = b_a_f[64 * h + lane], biasb = b_a_b[64 * h + lane];
                int lri[32];
#pragma unroll
                for (int q4 = 0; q4 < 8; ++q4) { const f32x4 t_ = *(const f32x4*)(LR + (size_t)(R0 + rw0 + (lane & 15)) * 32 + 4 * q4);
                    lri[4 * q4] = __float_as_int(t_.x); lri[4 * q4 + 1] = __float_as_int(t_.y); lri[4 * q4 + 2] = __float_as_int(t_.z); lri[4 * q4 + 3] = __float_as_int(t_.w); }
                unsigned short qraw[16], kraw[16];
                { const bf16* qp = ACT1 + (size_t)(R0 + rw0) * NACT + 64 * h + lane;
#pragma unroll
                  for (int i = 0; i < 16; ++i) { qraw[i] = qp[(size_t)i * NACT]; kraw[i] = qp[(size_t)i * NACT + 512]; } }
                { const bf16* vp = ACT1 + (size_t)(R0 + rw0) * NACT + 1024 + 128 * h;
#pragma unroll
                  for (int k2 = 0; k2 < 4; ++k2) { const int idx = lane + 64 * k2, row = idx >> 4, c16 = idx & 15;
                    *(LAS v4u*)(gl + 35840 + (rw0 + row) * 272 + 16 * c16) = *(const v4u*)(vp + (size_t)row * NACT + 8 * c16); } }
                float cf[16], cb[16];
#pragma unroll
                for (int i = 0; i < 16; ++i) { float zf = biasf, zb = biasb;
#pragma unroll
                    for (int r2 = 0; r2 < 16; ++r2) { zf += __int_as_float(__builtin_amdgcn_readlane(lri[r2], i)) * wuf[r2]; zb += __int_as_float(__builtin_amdgcn_readlane(lri[16 + r2], i)) * wub[r2]; }
                    cf[i] = logsigf_(zf) * (1.f / 16.f); cb[i] = logsigf_(zb) * (1.f / 16.f); }
#pragma unroll
                for (int i = 1; i < 16; ++i) cf[i] += cf[i - 1];
#pragma unroll
                for (int i = 14; i >= 0; --i) cb[i] += cb[i + 1];
                LAS float* segp = (LAS float*)(gl + 53248 + 512);
                segp[gwv * 64 + lane] = cf[15]; segp[256 + gwv * 64 + lane] = cb[0];
                __syncthreads();
                float offf = 0.f, offb = 0.f;
#pragma unroll
                for (int w2 = 0; w2 < 4; ++w2) { if (w2 < gwv) offf += segp[w2 * 64 + lane]; if (w2 > gwv) offb += segp[256 + w2 * 64 + lane]; }
#pragma unroll
                for (int i = 0; i < 16; ++i) { const int rho = rw0 + i;
                    const float ef = __expf(offf + cf[i]), eb_ = __expf(offb + cb[i]); const float qv = bf2f(qraw[i]), kv = bf2f(kraw[i]);
                    LAS bf16* qe = (LAS bf16*)(gl + rho * 272) + lane; LAS bf16* ke = (LAS bf16*)(gl + 17408 + rho * 144) + lane;
                    qe[0] = (bf16)f2bf(qv * ef); qe[64] = (bf16)f2bf(qv * eb_);
                    ke[0] = (bf16)f2bf(kv * __builtin_amdgcn_rcpf(ef)); ke[4608] = (bf16)f2bf(kv * __builtin_amdgcn_rcpf(eb_)); }
            }
            __syncthreads();
            bf16x8 qf[8];
#pragma unroll
            for (int ks = 0; ks < 8; ++ks) qf[ks] = *(const LAS bf16x8*)(gl + itok * 272 + 2 * (16 * ks + 8 * hh));
            bf16x8 pf[2][2];
#pragma unroll
            for (int jb = 0; jb < 2; ++jb) {
                f32x16 Xf, Xb;
#pragma unroll
                for (int i = 0; i < 16; ++i) { Xf[i] = 0.f; Xb[i] = 0.f; }
                if (jb <= ib) {
#pragma unroll
                    for (int ks = 0; ks < 4; ++ks) { const bf16x8 kf = *(const LAS bf16x8*)(gl + 17408 + (32 * jb + l31) * 144 + 2 * (16 * ks + 8 * hh)); Xf = MFMA32(kf, qf[ks], Xf); } }
                if (jb >= ib) {
#pragma unroll
                    for (int ks = 0; ks < 4; ++ks) { const bf16x8 kb = *(const LAS bf16x8*)(gl + 26624 + (32 * jb + l31) * 144 + 2 * (16 * ks + 8 * hh)); Xb = MFMA32(kb, qf[4 + ks], Xb); } }
                float pv[16];
#pragma unroll
                for (int r2 = 0; r2 < 16; ++r2) { const int j = 32 * jb + crow(r2, hh); pv[r2] = ((j <= itok) ? Xf[r2] : 0.f) + ((j >= itok) ? Xb[r2] : 0.f); }
#pragma unroll
                for (int s = 0; s < 2; ++s) { v4u pk; pk.x = pk2(pv[8 * s], pv[8 * s + 1]); pk.y = pk2(pv[8 * s + 2], pv[8 * s + 3]); pk.z = pk2(pv[8 * s + 4], pv[8 * s + 5]); pk.w = pk2(pv[8 * s + 6], pv[8 * s + 7]);
                    pf[jb][s] = __builtin_bit_cast(bf16x8, pk); }
            }
            f32x16 O[2]; float ss = 0.f;
#pragma unroll
            for (int eb = 0; eb < 2; ++eb) {
                f32x16 acc;
#pragma unroll
                for (int i = 0; i < 16; ++i) acc[i] = 0.f;
#pragma unroll
                for (int ks = 0; ks < 8; ++ks) acc = MFMA32(Sfr[eb][ks], qf[ks], acc);
#pragma unroll
                for (int jb = 0; jb < 2; ++jb)
#pragma unroll
                    for (int s = 0; s < 2; ++s) {
                        const LAS unsigned char* vp = gl + 35840 + (32 * jb + 16 * s + 4 * hh + qq) * 272 + 2 * (64 * eh + 32 * eb) + 32 * blk + 8 * pp;
                        const s16x4 vlo = __builtin_bit_cast(s16x4, __builtin_amdgcn_ds_read_tr16_b64_v4i16((LAS v4i16_t*)vp));
                        const s16x4 vhi = __builtin_bit_cast(s16x4, __builtin_amdgcn_ds_read_tr16_b64_v4i16((LAS v4i16_t*)(vp + 8 * 272)));
                        acc = MFMA32(__builtin_shufflevector(vlo, vhi, 0, 1, 2, 3, 4, 5, 6, 7), pf[jb][s], acc);
                    }
                O[eb] = acc;
#pragma unroll
                for (int i = 0; i < 16; ++i) ss += acc[i] * acc[i];
            }
            ss += __shfl_xor(ss, 32);
            if (hh == 0) xch[gwv * 32 + l31] = ss;
            __syncthreads();
            const float rs = rsqrtf((ss + xch[(gwv ^ 2) * 32 + l31]) * (1.f / 128.f) + EPS);
            bf16* yp = YA + (size_t)(R0 + itok) * 2048 + 128 * h + 64 * eh + 4 * hh;
#pragma unroll
            for (int eb = 0; eb < 2; ++eb)
#pragma unroll
                for (int g4 = 0; g4 < 4; ++g4) { const int e0 = 64 * eh + 32 * eb + 8 * g4 + 4 * hh; const f32x4 w = *(const f32x4*)(gla_onorm_w + e0); const v2u r_ = rr[eb][g4];
                    v2u o; o.x = pk2(O[eb][4 * g4] * rs * w.x * siluf_(bflo(r_.x)), O[eb][4 * g4 + 1] * rs * w.y * siluf_(bfhi(r_.x)));
                    o.y = pk2(O[eb][4 * g4 + 2] * rs * w.z * siluf_(bflo(r_.y)), O[eb][4 * g4 + 3] * rs * w.w * siluf_(bfhi(r_.y)));
                    *(v2u*)(yp + 32 * eb + 8 * g4) = o; }
        }
        __syncthreads(); }
        SEAM(5);
    }

    if (IN(6)) { for (int rep_ = 0; rep_ <= RPT(6); ++rep_) {
        pg8::Gemm g{YA, WPG, ML, DM, DM}; pg8::StaticOrder S; S.init(ML, DM, G_, bid);
        epi::EpiMrg2 E{GB, MRG};
        pg8::gemm_phase<epi::EpiMrg2, pg8::StaticOrder, false, true>(lds, g, S, E);
        __syncthreads(); }
        SEAM(6);
    }

    if (IN(7)) { for (int rep_ = 0; rep_ <= RPT(7); ++rep_) {
        pg8::Gemm g{MRG, WO, ML, DM, DM}; pg8::StaticOrder S; S.init(ML, DM, G_, bid);
        epi::EpiRes E{x, out, MOD + 2 * DM};
        pg8::gemm_phase<epi::EpiRes, pg8::StaticOrder, false, true>(lds, g, S, E);
        __syncthreads(); }
        SEAM(7);
    }

    if (IN(8)) { for (int rep_ = 0; rep_ <= RPT(8); ++rep_) {
        for (int r = gw; r < ML; r += 2 * NGW) {
            const int r2 = r + NGW; const bool hb = r2 < ML; const int rb = hb ? r2 : r;
            norm_mod_row2(out + (size_t)r * DM, out + (size_t)rb * DM, hb, norm2_w, MOD + (size_t)(r / SEQ) * 12288, MOD + (size_t)(rb / SEQ) * 12288, 3 * DM, H2 + (size_t)r * DM, H2 + (size_t)rb * DM, lane);
        }
        __syncthreads(); }
        SEAM(8);
    }

    if (IN(9)) { for (int rep_ = 0; rep_ <= RPT(9); ++rep_) {
        pg8::Gemm g{H2, WUP, 34 * 256, NUP, DM}; pg8::StaticOrder S; S.init(34 * 256, NUP, G_, bid); S.conv = 1;
        epi::EpiConv E{ACT2, conv_w, conv_b, (LAS unsigned*)(lds + 131072)};
        pg8::gemm_phase<epi::EpiConv, pg8::StaticOrder, true, true>(lds, g, S, E);
        __syncthreads(); }
        SEAM(9);
    }

    if (IN(10)) { for (int rep_ = 0; rep_ <= RPT(10); ++rep_) {
        pg8::Gemm g{ACT2, WDN, ML, DM, DFF}; pg8::StaticOrder S; S.init(ML, DM, G_, bid);
        epi::EpiRes E{out, out, MOD + 5 * DM};
        pg8::gemm_phase<epi::EpiRes, pg8::StaticOrder, false, true>(lds, g, S, E);
    } }
#undef IN
#undef SEAM
}

#ifndef MK_SPLIT
#define MK_SPLIT 0
#endif
constexpr int NPHASE = 11;
#ifndef MK_RPTH
#define MK_RPTH 0
#endif
extern "C" void kernel_launch(void* const* d_in, const int* in_sizes, int n_in, void* d_out, int out_size, void* d_ws, size_t ws_size, hipStream_t stream) {
    static int grid = 0;
    if (grid == 0) {
        if (n_in != 30 || out_size != ML * DM || ws_size < WS_END) { fprintf(stderr, "kernel_launch: unexpected problem (n_in %d out %d ws %zu)\n", n_in, out_size, ws_size); grid = -1; return; }
        int dev = 0, cus = 0, per_cu = 0;
        hipGetDevice(&dev); hipDeviceGetAttribute(&cus, hipDeviceAttributeMultiprocessorCount, dev);
        if (hipFuncSetAttribute((const void*)mega_fwd, hipFuncAttributeMaxDynamicSharedMemorySize, LDS_BYTES) != hipSuccess) { fprintf(stderr, "kernel_launch: hipFuncSetAttribute failed\n"); grid = -1; return; }
        if (hipOccupancyMaxActiveBlocksPerMultiprocessor(&per_cu, (const void*)mega_fwd, NT, LDS_BYTES) != hipSuccess || per_cu < 1) per_cu = 1;
        (void)hipGetLastError();
        grid = cus * per_cu;
    }
    if (grid < 0) return;
    Args a{};
    for (int i = 0; i < 30; ++i) a.in[i] = (const float*)d_in[i];
    a.out = (float*)d_out; a.ws = (unsigned char*)d_ws;
#if MK_SPLIT
    for (int p = 0; p < NPHASE; ++p) for (int q = 0; q <= ((MK_RPTH >> p) & 1); ++q) { a.ph_lo = p; a.ph_hi = p + 1; hipLaunchKernelGGL(mega_fwd, dim3(grid), dim3(NT), LDS_BYTES, stream, a); }
#else
    a.ph_lo = 0; a.ph_hi = NPHASE;
    void* kargs[] = {&a};
    hipError_t e = hipLaunchCooperativeKernel((const void*)mega_fwd, dim3(grid), dim3(NT), kargs, LDS_BYTES, stream);
    if (e != hipSuccess) fprintf(stderr, "cooperative launch failed: %s (grid %d)\n", hipGetErrorString(e), grid);
#endif
}
```

```cpp
#include <hip/hip_runtime.h>
#include <hip/hip_cooperative_groups.h>
#include <cstdio>
#include <cstdint>
namespace cg = cooperative_groups;
namespace pg8 {
#define PG8_LAS __attribute__((address_space(3)))
typedef unsigned short bf16_t;
typedef short bf16x8 __attribute__((ext_vector_type(8)));
typedef float f32x4 __attribute__((ext_vector_type(4)));
typedef unsigned u32x4 __attribute__((ext_vector_type(4)));
constexpr int BM = 256, BK = 64, HALF = 128, HTB = HALF * BK * 2  , STAGE_BYTES = 8 * HTB, NXCD = 8, WGM = 8;

__host__ __device__ __forceinline__ int lds_byte(int r, int c) { const int st = (r >> 4) * 2 + (c >> 5), rr = r & 15, cc = c & 31, ob = rr * 64 + cc * 2; return st * 1024 + (ob ^ (((ob >> 9) & 1) << 5)); }
__host__ __device__ __forceinline__ void stage_rc(int b, int& R, int& C) { const int st = b / 1024, sb = b % 1024, swz = sb ^ (((sb >> 9) & 1) << 5); R = (st >> 1) * 16 + swz / 64; C = (st & 1) * 32 + (swz % 64) / 2; }
__host__ __device__ __forceinline__ int perm32(int rho) { const int n = rho >> 4, i = rho & 15; return 8 * (i >> 2) + 4 * n + (i & 3); }

struct Unit { int pm, pn; };
struct Gemm { const bf16_t* A; const bf16_t* Bt; int M, N, K; };

struct StaticOrder {
    int nM, nN, nwg, G, c, conv;
    __host__ __device__ void init(int M, int N, int G_, int c_) { nM = M / BM; nN = N / BM; nwg = nM * nN; G = G_; c = c_; conv = 0; }
    __host__ __device__ long arow(int pm) const { return conv ? (long)(pm / 17) * 4096 + 254 * (pm % 17) - 1 : (long)pm * BM; }
    __host__ __device__ bool next(int i, Unit& u) const {
        const long L = (long)i * G + c; if (L >= nwg) return false;
        int wgid = (int)L; { const int q = nwg / NXCD, r = nwg % NXCD, xcd = wgid % NXCD, off = wgid / NXCD; wgid = (xcd < r ? xcd * (q + 1) : r * (q + 1) + (xcd - r) * q) + off; }
        const int nig = WGM * nN, gid = wgid / nig, fm = gid * WGM, gsz = (nM - fm) < WGM ? (nM - fm) : WGM;
        u.pm = fm + ((wgid % nig) % gsz); u.pn = (wgid % nig) / gsz; return true;
    }
    __device__ __forceinline__ void a_ready(const Unit&) const {}
    __device__ __forceinline__ void done(const Unit&) const {}
};

typedef float f32x2c_t __attribute__((ext_vector_type(2))); typedef __bf16 bf16x2c_t __attribute__((ext_vector_type(2)));
__device__ __forceinline__ unsigned cvt_pk_bf16(float lo, float hi) { f32x2c_t v = {lo, hi}; bf16x2c_t b = __builtin_convertvector(v, bf16x2c_t); return __builtin_bit_cast(unsigned, b); }

template <class Epi, class Sched, bool ALIGN_EPI = false, bool SP2 = false>
__device__ __forceinline__ void gemm_phase(PG8_LAS unsigned char* lds, const Gemm g, const Sched& S, const Epi& E) {
    const int tid = threadIdx.x, wid = __builtin_amdgcn_readfirstlane(tid >> 6), lane = tid & 63, wr = wid >> 2, wc = wid & 3, fr = lane & 15, fq = lane >> 4;
    const int K = g.K, nt = K / BK;
    unsigned voffA[2], voffB[2];
#pragma unroll
    for (int i = 0; i < 2; ++i) { int R, C; stage_rc(tid * 16 + i * 8192, R, C); const int Rb = Epi::PERM ? ((R & ~31) + perm32(R & 31)) : R;
        voffA[i] = (unsigned)(R * K + C) * 2u; voffB[i] = (unsigned)(Rb * K + C) * 2u; }
    const size_t kstep = (size_t)(BK * 2);
    const size_t hstep = (size_t)HALF * K * 2;
    const size_t tstep = 2 * hstep;
    const unsigned ldsw = (unsigned)wid * 1024u;
    const int aoff = lds_byte(wr * 64 + fr, fq * 8), boff = lds_byte(wc * 32 + fr, fq * 8);
#define PG8_SA(b, h) (((b) * 2 + (h)) * HTB)
#define PG8_SB(b, h) ((4 + (b) * 2 + (h)) * HTB)
#define PG8_STAGE(bufoff, gbase, voff) do { _Pragma("unroll") for (int _i = 0; _i < 2; ++_i) \
        __builtin_amdgcn_global_load_lds((const unsigned*)((const char*)(gbase) + (voff)[_i]), (PG8_LAS unsigned*)(lds + (bufoff) + ldsw + _i * 8192), 16, 0, 0); } while (0)
#define PG8_LDA(dst, b, h) do { _Pragma("unroll") for (int m = 0; m < 4; ++m) _Pragma("unroll") for (int k = 0; k < 2; ++k) dst[m][k] = *(const PG8_LAS bf16x8*)(lds + PG8_SA(b, h) + aoff + m * 2048 + k * 1024); } while (0)
#define PG8_LDB(dst, b, h) do { _Pragma("unroll") for (int n = 0; n < 2; ++n) _Pragma("unroll") for (int k = 0; k < 2; ++k) dst[n][k] = *(const PG8_LAS bf16x8*)(lds + PG8_SB(b, h) + boff + n * 2048 + k * 1024); } while (0)
#define PG8_MMA(ai, bj, At, Bt) do { __builtin_amdgcn_s_setprio(1); _Pragma("unroll") for (int m = 0; m < 4; ++m) _Pragma("unroll") for (int n = 0; n < 2; ++n) _Pragma("unroll") for (int k = 0; k < 2; ++k) \
        acc[ai][bj][m][n] = __builtin_amdgcn_mfma_f32_16x16x32_bf16(Bt[n][k], At[m][k], acc[ai][bj][m][n], 0, 0, 0); __builtin_amdgcn_s_setprio(0); } while (0)
#define PG8_WAIT_V(n) asm volatile("s_waitcnt vmcnt(" #n ")" ::: "memory")
#define PG8_WAIT_L(n) asm volatile("s_waitcnt lgkmcnt(" #n ")" ::: "memory")
#define PG8_BAR __builtin_amdgcn_s_barrier()
#define PG8_SCHED __builtin_amdgcn_sched_barrier(0)
    Unit cur, nxt; int ui = 0;
    if (!S.next(0, cur)) return;
    f32x4 acc[2][2][4][2];
#pragma unroll
    for (int a = 0; a < 2; ++a)
#pragma unroll
        for (int b = 0; b < 2; ++b)
#pragma unroll
            for (int m = 0; m < 4; ++m)
#pragma unroll
                for (int n = 0; n < 2; ++n) acc[a][b][m][n] = (f32x4){0.f, 0.f, 0.f, 0.f};
    bf16x8 At[4][2], B0[2][2], B1[2][2];
    const char* cA = (const char*)g.A + S.arow(cur.pm) * (long)K * 2; const char* cB = (const char*)g.Bt + (size_t)cur.pn * tstep;
    S.a_ready(cur);
    if constexpr (SP2) {
        PG8_STAGE(PG8_SB(0, 0), cB, voffB); PG8_STAGE(PG8_SB(0, 1), cB + hstep, voffB); PG8_STAGE(PG8_SA(0, 0), cA, voffA); PG8_STAGE(PG8_SA(0, 1), cA + hstep, voffA);
        if (wr == 1) PG8_BAR;
        PG8_WAIT_V(2); PG8_BAR;
        PG8_STAGE(PG8_SB(1, 0), cB + kstep, voffB); PG8_STAGE(PG8_SA(1, 0), cA + kstep, voffA); PG8_STAGE(PG8_SB(1, 1), cB + hstep + kstep, voffB);
        PG8_WAIT_V(6); PG8_BAR;
    } else {
        PG8_STAGE(PG8_SB(0, 0), cB, voffB); PG8_STAGE(PG8_SA(0, 0), cA, voffA); PG8_STAGE(PG8_SB(0, 1), cB + hstep, voffB); PG8_STAGE(PG8_SA(0, 1), cA + hstep, voffA);
        if (wr == 1) PG8_BAR;
        PG8_WAIT_V(4); PG8_BAR;
        PG8_STAGE(PG8_SB(1, 0), cB + kstep, voffB); PG8_STAGE(PG8_SA(1, 0), cA + kstep, voffA); PG8_STAGE(PG8_SB(1, 1), cB + hstep + kstep, voffB);
        PG8_WAIT_V(6); PG8_BAR;
    }
    for (;;) {
        const bool has_next = S.next(ui + 1, nxt);
        const char* nA = has_next ? (const char*)g.A + S.arow(nxt.pm) * (long)K * 2 : cA; const char* nB = has_next ? (const char*)g.Bt + (size_t)nxt.pn * tstep : cB;
        for (int t = 0; t < nt; t += 2) {
            if constexpr (Epi::MIDK > 0) { if (t == Epi::MIDK) E.mid(acc, cur, wr, wc, fr, fq); }
            const bool last = (t == nt - 2);
            const char* a1 = cA + (size_t)(t + 1) * kstep;
            const char* a2 = last ? nA : cA + (size_t)(t + 2) * kstep; const char* b2 = last ? nB : cB + (size_t)(t + 2) * kstep;
            const char* a3 = a2 + kstep; const char* b3 = b2 + kstep;
            if (last && has_next) S.a_ready(nxt);
            if constexpr (SP2) {
            PG8_LDB(B0, 0, 0); PG8_LDB(B1, 0, 1); PG8_SCHED; PG8_LDA(At, 0, 0); PG8_STAGE(PG8_SA(1, 1), a1 + hstep, voffA);
            PG8_WAIT_V(8); PG8_WAIT_L(0); PG8_BAR; PG8_MMA(0, 0, At, B0); PG8_MMA(0, 1, At, B1); PG8_BAR; PG8_SCHED;
            PG8_LDA(At, 0, 1); PG8_STAGE(PG8_SB(0, 0), b2, voffB); PG8_STAGE(PG8_SB(0, 1), b2 + hstep, voffB); PG8_STAGE(PG8_SA(0, 0), a2, voffA);
            PG8_WAIT_V(8); PG8_WAIT_L(0); PG8_BAR; PG8_MMA(1, 0, At, B0); PG8_MMA(1, 1, At, B1); PG8_BAR; PG8_SCHED;
            PG8_LDB(B0, 1, 0); PG8_LDB(B1, 1, 1); PG8_SCHED; PG8_LDA(At, 1, 0); PG8_STAGE(PG8_SA(0, 1), a2 + hstep, voffA);
            PG8_WAIT_V(8); PG8_WAIT_L(0); PG8_BAR; PG8_MMA(0, 0, At, B0); PG8_MMA(0, 1, At, B1); PG8_BAR; PG8_SCHED;
            PG8_LDA(At, 1, 1); PG8_STAGE(PG8_SB(1, 0), b3, voffB); PG8_STAGE(PG8_SB(1, 1), b3 + hstep, voffB); PG8_STAGE(PG8_SA(1, 0), a3, voffA);
            PG8_WAIT_V(8); PG8_WAIT_L(0); PG8_BAR; PG8_MMA(1, 0, At, B0); PG8_MMA(1, 1, At, B1); PG8_BAR; PG8_SCHED;
            } else {
            PG8_LDB(B0, 0, 0); PG8_SCHED; PG8_LDA(At, 0, 0); PG8_STAGE(PG8_SA(1, 1), a1 + hstep, voffA);
            PG8_WAIT_L(8); PG8_BAR; PG8_WAIT_L(0); PG8_MMA(0, 0, At, B0); PG8_BAR; PG8_SCHED;
            PG8_LDB(B1, 0, 1); PG8_STAGE(PG8_SB(0, 0), b2, voffB);
            PG8_BAR; PG8_WAIT_L(0); PG8_MMA(0, 1, At, B1); PG8_BAR;
            PG8_LDA(At, 0, 1); PG8_STAGE(PG8_SA(0, 0), a2, voffA);
            PG8_BAR; PG8_WAIT_L(0); PG8_MMA(1, 0, At, B0); PG8_BAR; PG8_SCHED;
            PG8_STAGE(PG8_SB(0, 1), b2 + hstep, voffB);
            PG8_WAIT_V(6); PG8_BAR; PG8_MMA(1, 1, At, B1); PG8_BAR;
            PG8_LDB(B0, 1, 0); PG8_SCHED; PG8_LDA(At, 1, 0); PG8_STAGE(PG8_SA(0, 1), a2 + hstep, voffA);
            PG8_WAIT_L(8); PG8_BAR; PG8_WAIT_L(0); PG8_MMA(0, 0, At, B0); PG8_BAR; PG8_SCHED;
            PG8_LDB(B1, 1, 1); PG8_STAGE(PG8_SB(1, 0), b3, voffB);
            PG8_BAR; PG8_WAIT_L(0); PG8_MMA(0, 1, At, B1); PG8_BAR;
            PG8_LDA(At, 1, 1); PG8_STAGE(PG8_SA(1, 0), a3, voffA);
            PG8_BAR; PG8_WAIT_L(0); PG8_MMA(1, 0, At, B0); PG8_BAR; PG8_SCHED;
            PG8_STAGE(PG8_SB(1, 1), b3 + hstep, voffB);
            PG8_WAIT_V(6); PG8_BAR; PG8_MMA(1, 1, At, B1); PG8_BAR;
            }
        }
        if constexpr (ALIGN_EPI) { if (wr == 0) PG8_BAR; }
        if constexpr (!Epi::AFTER_DRAIN) { E(acc, cur, wr, wc, fr, fq); S.done(cur); }
        if (!has_next) break;
#pragma unroll
        for (int a = 0; a < 2; ++a)
#pragma unroll
            for (int b = 0; b < 2; ++b)
#pragma unroll
                for (int m = 0; m < 4; ++m)
#pragma unroll
                    for (int n = 0; n < 2; ++n) acc[a][b][m][n] = (f32x4){0.f, 0.f, 0.f, 0.f};
        cur = nxt; cA = nA; cB = nB; ++ui;
        if constexpr (ALIGN_EPI) { if (wr == 1) PG8_BAR; }
    }
    PG8_WAIT_V(0);
    if constexpr (!ALIGN_EPI) { if (wr == 0) PG8_BAR; }
    PG8_BAR;
    if constexpr (Epi::AFTER_DRAIN) { E.fused(acc, cur, wr, wc, fr, fq, lds, wid, lane); S.done(cur); }
#undef PG8_SA
#undef PG8_SB
#undef PG8_STAGE
#undef PG8_LDA
#undef PG8_LDB
#undef PG8_MMA
#undef PG8_WAIT_V
#undef PG8_WAIT_L
#undef PG8_BAR
#undef PG8_SCHED
}
}

#define GAS __attribute__((address_space(1)))
#define LAS __attribute__((address_space(3)))
typedef unsigned short bf16;
typedef unsigned v4u __attribute__((ext_vector_type(4)));
typedef unsigned v2u __attribute__((ext_vector_type(2)));
typedef float f32x4 __attribute__((ext_vector_type(4)));
typedef float f32x16 __attribute__((ext_vector_type(16)));
typedef short bf16x8 __attribute__((ext_vector_type(8)));
typedef short s16x4 __attribute__((ext_vector_type(4)));
typedef short v4i16_t __attribute__((ext_vector_type(4)));
#define LDS_WAIT() asm volatile("s_waitcnt lgkmcnt(0)" ::: "memory")
#define MFMA16(a, b, c) __builtin_amdgcn_mfma_f32_16x16x32_bf16((a), (b), (c), 0, 0, 0)
#define MFMA32(a, b, c) __builtin_amdgcn_mfma_f32_32x32x16_bf16((a), (b), (c), 0, 0, 0)

typedef float f32x2_t __attribute__((ext_vector_type(2))); typedef __bf16 bf16x2_t __attribute__((ext_vector_type(2)));
__device__ __forceinline__ unsigned pk2(float lo, float hi) { f32x2_t v = {lo, hi}; bf16x2_t b = __builtin_convertvector(v, bf16x2_t); return __builtin_bit_cast(unsigned, b); }
__device__ __forceinline__ unsigned f2bf(float f) { return pk2(f, f) & 0xffffu; }
__device__ __forceinline__ float bf2f(unsigned short h) { return __builtin_bit_cast(float, (unsigned)h << 16); }
__device__ __forceinline__ float bflo(unsigned u) { return __builtin_bit_cast(float, u << 16); }
__device__ __forceinline__ float bfhi(unsigned u) { return __builtin_bit_cast(float, u & 0xffff0000u); }
__device__ __forceinline__ float wave_sum(float v) {
#pragma unroll
    for (int o = 1; o < 64; o <<= 1) v += __shfl_xor(v, o);
    return v;
}
__device__ __forceinline__ float sigmoidf_(float x) { return __builtin_amdgcn_rcpf(1.f + __expf(-x)); }
__device__ __forceinline__ float siluf_(float x) { return x * __builtin_amdgcn_rcpf(1.f + __expf(-x)); }
__device__ __forceinline__ float logsigf_(float z) { return fminf(z, 0.f) - __logf(1.f + __expf(-fabsf(z))); }
__device__ __forceinline__ int crow(int r, int hi) { return (r & 3) + 8 * (r >> 2) + 4 * hi; }

constexpr int DM = 2048, NB = 2, SEQ = 4096, CTXL = 256;
constexpr int ML = NB * SEQ, MC = NB * CTXL, MT = ML + MC;
constexpr int NCAT = 10496, NACT = 6144, DFF = 5632, NUP = 11264, DIN = 6176;
constexpr int NITEM1 = 2 * 8 * 2 * 68;
constexpr float EPS = 1e-6f;
constexpr float LAM_INIT = 0.2f;
constexpr int NW = 8, NT = 512;
constexpr int LDS_BYTES = 147456;

constexpr size_t MiB = 1u << 20;
constexpr size_t WS_LAM = 4096, WS_BAR = 8192, WS_TAB = 32768  , WS_MOD = 65536;
constexpr size_t WS_WPG = 277 * MiB, WS_WPD = 281 * MiB, WS_WO = 395 * MiB, WS_WDN = 1 * MiB;
constexpr size_t WS_H = 23 * MiB, WS_WCAT = 57 * MiB, WS_LR = 98 * MiB, WS_GDEC = 100 * MiB;
constexpr size_t WS_U = 23 * MiB, WS_T1 = 23 * MiB, WS_H2 = 23 * MiB, WS_WUP = 351 * MiB, WS_ACT2 = 111 * MiB;
constexpr size_t WS_ACT1 = 111 * MiB, WS_G = 213 * MiB, WS_U2 = 111 * MiB;
constexpr size_t WS_S = 287 * MiB, WS_MRG = 287 * MiB, WS_YA = 319 * MiB, WS_YB = 335 * MiB, WS_END = 403 * MiB;

struct Args { const float* in[30]; float* out; unsigned char* ws; int ph_lo, ph_hi; };

namespace epi {
using pg8::Unit; using pg8::f32x4; using pg8::u32x4; using pg8::cvt_pk_bf16; using pg8::BM; using pg8::HALF;
#define EPI_LOOP for (int ai = 0; ai < 2; ++ai) for (int m = 0; m < 4; ++m) for (int bj = 0; bj < 2; ++bj)

struct EpiP2 {
    static constexpr bool PERM = true, AFTER_DRAIN = false; static constexpr int MIDK = 0;
    bf16* ACT1; bf16* G; float* LR; const float* b_gate;
    __device__ __forceinline__ void operator()(const f32x4 (&acc)[2][2][4][2], const Unit& u, int wr, int wc, int fr, int fq) const {
        const int row0 = u.pm * BM + wr * 64 + fr, cin = wc * 32 + 8 * fq;
        if (u.pn < 24) {
            const float sc = (u.pn < 2) ? 0.125f : 1.0f;
#pragma unroll
            EPI_LOOP { const f32x4 v0 = acc[ai][bj][m][0] * sc, v1 = acc[ai][bj][m][1] * sc;
                u32x4 w; w.x = cvt_pk_bf16(v0[0], v0[1]); w.y = cvt_pk_bf16(v0[2], v0[3]); w.z = cvt_pk_bf16(v1[0], v1[1]); w.w = cvt_pk_bf16(v1[2], v1[3]);
                *(u32x4*)(ACT1 + (size_t)(row0 + ai * HALF + m * 16) * NACT + u.pn * BM + bj * HALF + cin) = w; }
        } else if (u.pn < 40) {
            if (u.pm < ML / BM) {
                const int c0 = (u.pn - 24) * BM + cin;
#pragma unroll
                EPI_LOOP { const int col = c0 + bj * HALF; const f32x4 b0 = *(const f32x4*)(b_gate + col), b1 = *(const f32x4*)(b_gate + col + 4);
                    const f32x4 v0 = acc[ai][bj][m][0] + b0, v1 = acc[ai][bj][m][1] + b1;
                    u32x4 w; w.x = cvt_pk_bf16(sigmoidf_(v0[0]), sigmoidf_(v0[1])); w.y = cvt_pk_bf16(sigmoidf_(v0[2]), sigmoidf_(v0[3]));
                    w.z = cvt_pk_bf16(sigmoidf_(v1[0]), sigmoidf_(v1[1])); w.w = cvt_pk_bf16(sigmoidf_(v1[2]), sigmoidf_(v1[3]));
                    *(u32x4*)(G + (size_t)(row0 + ai * HALF + m * 16) * 4096 + col) = w; }
            }
        } else {
            if (wc == 0) {
#pragma unroll
                for (int ai = 0; ai < 2; ++ai)
#pragma unroll
                    for (int m = 0; m < 4; ++m) { float* p = LR + (size_t)(row0 + ai * HALF + m * 16) * 32 + 8 * fq;
                        *(f32x4*)p = acc[ai][0][m][0]; *(f32x4*)(p + 4) = acc[ai][0][m][1]; }
            }
        }
    }
};
struct EpiMrg2 {
    static constexpr bool PERM = true, AFTER_DRAIN = false; static constexpr int MIDK = 16;
    const bf16* G; bf16* MRG;
    __device__ __forceinline__ void mid(f32x4 (&acc)[2][2][4][2], const Unit& u, int wr, int wc, int fr, int fq) const {
        int row0 = u.pm * BM + wr * 64 + fr, c0 = u.pn * BM + wc * 32 + 8 * fq;
        asm volatile("" : "+v"(row0), "+v"(c0));
#pragma unroll
        for (int ai = 0; ai < 2; ++ai) {
            u32x4 ga[4][2], gb[4][2];
#pragma unroll
            for (int m = 0; m < 4; ++m)
#pragma unroll
                for (int bj = 0; bj < 2; ++bj) { const bf16* gp = G + (size_t)(row0 + ai * HALF + m * 16) * 4096 + c0 + bj * HALF; ga[m][bj] = *(const u32x4*)gp; gb[m][bj] = *(const u32x4*)(gp + 2048); }
#pragma unroll
            for (int m = 0; m < 4; ++m)
#pragma unroll
                for (int bj = 0; bj < 2; ++bj) { const u32x4 a = ga[m][bj], b = gb[m][bj];
                    f32x4 v0 = acc[ai][bj][m][0], v1 = acc[ai][bj][m][1];
#define RC_(x) __builtin_amdgcn_rcpf(x)
                    v0[0] *= bflo(a.x) * RC_(bflo(b.x)); v0[1] *= bfhi(a.x) * RC_(bfhi(b.x)); v0[2] *= bflo(a.y) * RC_(bflo(b.y)); v0[3] *= bfhi(a.y) * RC_(bfhi(b.y));
                    v1[0] *= bflo(a.z) * RC_(bflo(b.z)); v1[1] *= bfhi(a.z) * RC_(bfhi(b.z)); v1[2] *= bflo(a.w) * RC_(bflo(b.w)); v1[3] *= bfhi(a.w) * RC_(bfhi(b.w));
#undef RC_
                    acc[ai][bj][m][0] = v0; acc[ai][bj][m][1] = v1; }
            __builtin_amdgcn_sched_barrier(0);
        }
    }
    __device__ __forceinline__ void operator()(const f32x4 (&acc)[2][2][4][2], const Unit& u, int wr, int wc, int fr, int fq) const {
        const int row0 = u.pm * BM + wr * 64 + fr, c0 = u.pn * BM + wc * 32 + 8 * fq;
        u32x4 gv[2][4][2];
#pragma unroll
        EPI_LOOP gv[ai][m][bj] = *(const u32x4*)(G + (size_t)(row0 + ai * HALF + m * 16) * 4096 + 2048 + c0 + bj * HALF);
#pragma unroll
        EPI_LOOP { const int row = row0 + ai * HALF + m * 16, col = c0 + bj * HALF; const u32x4 g = gv[ai][m][bj];
            const f32x4 a0 = acc[ai][bj][m][0], a1 = acc[ai][bj][m][1];
            u32x4 w; w.x = cvt_pk_bf16(a0[0] * bflo(g.x), a0[1] * bfhi(g.x)); w.y = cvt_pk_bf16(a0[2] * bflo(g.y), a0[3] * bfhi(g.y));
            w.z = cvt_pk_bf16(a1[0] * bflo(g.z), a1[1] * bfhi(g.z)); w.w = cvt_pk_bf16(a1[2] * bflo(g.w), a1[3] * bfhi(g.w));
            *(u32x4*)(MRG + (size_t)row * DM + col) = w; }
    }
};
struct EpiRes {
    static constexpr bool PERM = true, AFTER_DRAIN = false; static constexpr int MIDK = 0;
    const float* base; float* out; const float* gate;
    __device__ __forceinline__ void operator()(const f32x4 (&acc)[2][2][4][2], const Unit& u, int wr, int wc, int fr, int fq) const {
        const int row0 = u.pm * BM + wr * 64 + fr, c0 = u.pn * BM + wc * 32 + 8 * fq;
        const float* gb = gate + (size_t)((u.pm * BM) / SEQ) * 12288 + c0;
        f32x4 gg[2][2];
#pragma unroll
        for (int bj = 0; bj < 2; ++bj) { gg[bj][0] = *(const f32x4*)(gb + bj * HALF); gg[bj][1] = *(const f32x4*)(gb + bj * HALF + 4); }
#pragma unroll
        for (int ai = 0; ai < 2; ++ai) {
            f32x4 xb[4][2][2];
#pragma unroll
            for (int m = 0; m < 4; ++m)
#pragma unroll
                for (int bj = 0; bj < 2; ++bj) { const float* bp = base + (size_t)(row0 + ai * HALF + m * 16) * DM + c0 + bj * HALF; xb[m][bj][0] = *(const f32x4*)bp; xb[m][bj][1] = *(const f32x4*)(bp + 4); }
#pragma unroll
            for (int m = 0; m < 4; ++m)
#pragma unroll
                for (int bj = 0; bj < 2; ++bj) { float* p = out + (size_t)(row0 + ai * HALF + m * 16) * DM + c0 + bj * HALF;
                    *(f32x4*)p = xb[m][bj][0] + gg[bj][0] * acc[ai][bj][m][0]; *(f32x4*)(p + 4) = xb[m][bj][1] + gg[bj][1] * acc[ai][bj][m][1]; }
        }
    }
};
struct EpiPlain {
    static constexpr bool PERM = true, AFTER_DRAIN = false; static constexpr int MIDK = 0;
    bf16* O; int ldc;
    __device__ __forceinline__ void operator()(const f32x4 (&acc)[2][2][4][2], const Unit& u, int wr, int wc, int fr, int fq) const {
        const int row0 = u.pm * BM + wr * 64 + fr, c0 = u.pn * BM + wc * 32 + 8 * fq;
#pragma unroll
        EPI_LOOP { const f32x4 v0 = acc[ai][bj][m][0], v1 = acc[ai][bj][m][1];
            u32x4 w; w.x = cvt_pk_bf16(v0[0], v0[1]); w.y = cvt_pk_bf16(v0[2], v0[3]); w.z = cvt_pk_bf16(v1[0], v1[1]); w.w = cvt_pk_bf16(v1[2], v1[3]);
            *(u32x4*)(O + (size_t)(row0 + ai * HALF + m * 16) * ldc + c0 + bj * HALF) = w; }
    }
};
struct EpiConv {
    static constexpr bool PERM = true, AFTER_DRAIN = false; static constexpr int MIDK = 0;
    bf16* ACT2; const float* conv_w; const float* conv_b; __attribute__((address_space(3))) unsigned* halo;
    __device__ __forceinline__ void operator()(const f32x4 (&acc)[2][2][4][2], const Unit& u, int wr, int wc, int fr, int fq) const {
        unsigned P[2][4][8];
#pragma unroll
        for (int ai = 0; ai < 2; ++ai)
#pragma unroll
            for (int m = 0; m < 4; ++m)
#pragma unroll
                for (int bj = 0; bj < 2; ++bj) { const f32x4 v0 = acc[ai][bj][m][0], v1 = acc[ai][bj][m][1];
                    P[ai][m][4 * bj + 0] = cvt_pk_bf16(v0[0], v0[1]); P[ai][m][4 * bj + 1] = cvt_pk_bf16(v0[2], v0[3]);
                    P[ai][m][4 * bj + 2] = cvt_pk_bf16(v1[0], v1[1]); P[ai][m][4 * bj + 3] = cvt_pk_bf16(v1[2], v1[3]); }
#pragma unroll
        for (int ai = 0; ai < 2; ++ai) { const int rb = 2 * ai + wr;
            if (fr == 0) { __attribute__((address_space(3))) unsigned* hp = halo + (((rb * 2 + 0) * 4 + wc) * 4 + fq) * 8;
#pragma unroll
                for (int e = 0; e < 8; ++e) hp[e] = P[ai][0][e]; }
            if (fr == 15) { __attribute__((address_space(3))) unsigned* hp = halo + (((rb * 2 + 1) * 4 + wc) * 4 + fq) * 8;
#pragma unroll
                for (int e = 0; e < 8; ++e) hp[e] = P[ai][3][e]; } }
        asm volatile("s_waitcnt lgkmcnt(0)" ::: "memory");
        __builtin_amdgcn_s_barrier();
        asm volatile("" ::: "memory");
        const int c8 = u.pn * 128 + wc * 32 + 8 * fq;
        float wg[3][8], wv[3][8], bg[8], bv[8];
#pragma unroll
        for (int j = 0; j < 3; ++j) { const float* cw = conv_w + (size_t)j * NUP + c8;
            const f32x4 a0 = *(const f32x4*)cw, a1 = *(const f32x4*)(cw + 4), b0 = *(const f32x4*)(cw + DFF), b1 = *(const f32x4*)(cw + DFF + 4);
            wg[j][0] = a0[0]; wg[j][1] = a0[1]; wg[j][2] = a0[2]; wg[j][3] = a0[3]; wg[j][4] = a1[0]; wg[j][5] = a1[1]; wg[j][6] = a1[2]; wg[j][7] = a1[3];
            wv[j][0] = b0[0]; wv[j][1] = b0[1]; wv[j][2] = b0[2]; wv[j][3] = b0[3]; wv[j][4] = b1[0]; wv[j][5] = b1[1]; wv[j][6] = b1[2]; wv[j][7] = b1[3]; }
        { const f32x4 a0 = *(const f32x4*)(conv_b + c8), a1 = *(const f32x4*)(conv_b + c8 + 4), b0 = *(const f32x4*)(conv_b + DFF + c8), b1 = *(const f32x4*)(conv_b + DFF + c8 + 4);
          bg[0] = a0[0]; bg[1] = a0[1]; bg[2] = a0[2]; bg[3] = a0[3]; bg[4] = a1[0]; bg[5] = a1[1]; bg[6] = a1[2]; bg[7] = a1[3];
          bv[0] = b0[0]; bv[1] = b0[1]; bv[2] = b0[2]; bv[3] = b0[3]; bv[4] = b1[0]; bv[5] = b1[1]; bv[6] = b1[2]; bv[7] = b1[3]; }
        const int kt = u.pm % 17, bb = u.pm / 17;
#pragma unroll
        for (int ai = 0; ai < 2; ++ai) { const int rb = 2 * ai + wr;
#pragma unroll
            for (int m = 0; m < 4; ++m) {
                const int i = 128 * ai + 64 * wr + 16 * m + fr, t = 254 * kt + i - 1;
                unsigned up[8], dn[8];
#pragma unroll
                for (int e = 0; e < 8; ++e) {
                    const unsigned su = (fr == 15) ? P[ai][m > 0 ? m - 1 : 0][e] : P[ai][m][e];
                    const unsigned sd = (fr == 0) ? P[ai][m < 3 ? m + 1 : 3][e] : P[ai][m][e];
                    up[e] = (unsigned)__builtin_amdgcn_update_dpp(0, (int)su, 0x121, 0xf, 0xf, false);
                    dn[e] = (unsigned)__builtin_amdgcn_update_dpp(0, (int)sd, 0x12F, 0xf, 0xf, false);
                }
                if (m == 0 && fr == 0 && rb > 0) { const __attribute__((address_space(3))) unsigned* hp = halo + ((((rb - 1) * 2 + 1) * 4 + wc) * 4 + fq) * 8;
#pragma unroll
                    for (int e = 0; e < 8; ++e) up[e] = hp[e]; }
                if (m == 3 && fr == 15 && rb < 3) { const __attribute__((address_space(3))) unsigned* hp = halo + ((((rb + 1) * 2 + 0) * 4 + wc) * 4 + fq) * 8;
#pragma unroll
                    for (int e = 0; e < 8; ++e) dn[e] = hp[e]; }
                if (t == 0) {
#pragma unroll
                    for (int e = 0; e < 8; ++e) up[e] = 0u; }
                if (t == SEQ - 1) {
#pragma unroll
                    for (int e = 0; e < 8; ++e) dn[e] = 0u; }
                float o[8];
#pragma unroll
                for (int e2 = 0; e2 < 4; ++e2) {
                    const float g0 = bg[2 * e2] + wg[0][2 * e2] * bflo(up[e2]) + wg[1][2 * e2] * bflo(P[ai][m][e2]) + wg[2][2 * e2] * bflo(dn[e2]);
                    const float g1 = bg[2 * e2 + 1] + wg[0][2 * e2 + 1] * bfhi(up[e2]) + wg[1][2 * e2 + 1] * bfhi(P[ai][m][e2]) + wg[2][2 * e2 + 1] * bfhi(dn[e2]);
                    const float v0 = bv[2 * e2] + wv[0][2 * e2] * bflo(up[4 + e2]) + wv[1][2 * e2] * bflo(P[ai][m][4 + e2]) + wv[2][2 * e2] * bflo(dn[4 + e2]);
                    const float v1 = bv[2 * e2 + 1] + wv[0][2 * e2 + 1] * bfhi(up[4 + e2]) + wv[1][2 * e2 + 1] * bfhi(P[ai][m][4 + e2]) + wv[2][2 * e2 + 1] * bfhi(dn[4 + e2]);
                    o[2 * e2] = siluf_(g0) * v0; o[2 * e2 + 1] = siluf_(g1) * v1;
                }
                if (i >= 1 && i <= 254 && t < SEQ) {
                    u32x4 w; w.x = cvt_pk_bf16(o[0], o[1]); w.y = cvt_pk_bf16(o[2], o[3]); w.z = cvt_pk_bf16(o[4], o[5]); w.w = cvt_pk_bf16(o[6], o[7]);
                    *(u32x4*)(ACT2 + (size_t)(bb * SEQ + t) * DFF + c8) = w; }
            } }
    }
};
}

__device__ __forceinline__ void tr_item(const float* W, int ld, int k0, int col0, bf16* WT, int K, int row0, LAS float* scr, int lane, int dko = 0) {
#pragma unroll 8
    for (int i = 0; i < 32; ++i) { const int kk = 2 * i + (lane >> 5); scr[kk * 33 + (lane & 31)] = W[(size_t)(k0 + kk) * ld + col0 + (lane & 31)]; }
    LDS_WAIT(); asm volatile("" ::: "memory");
    const int c = lane & 7;
#pragma unroll
    for (int j = 0; j < 4; ++j) { const int n = (lane >> 3) + 8 * j; const LAS float* s = scr + (8 * c) * 33 + n;
        v4u o; o.x = pk2(s[0 * 33], s[1 * 33]); o.y = pk2(s[2 * 33], s[3 * 33]); o.z = pk2(s[4 * 33], s[5 * 33]); o.w = pk2(s[6 * 33], s[7 * 33]);
        *(v4u*)(WT + (size_t)(row0 + n) * K + dko + k0 + 8 * c) = o; }
    LDS_WAIT(); asm volatile("" ::: "memory");
}
#define TRJOB2(SRC, LD, KSRC, COL0, DST, KPITCH, DKO, ROW0, NCOLS) { const int nb_ = (NCOLS) / 32, ni_ = ((KSRC) / 64) * nb_; \
    if (r < ni_) { const int kb_ = r / nb_, nn_ = r % nb_; tr_item((SRC), (LD), 64 * kb_, (COL0) + 32 * nn_, (DST), (KPITCH), (ROW0) + 32 * nn_, scr, lane, (DKO)); continue; } r -= ni_; }
#define TRJOB(SRC, LD, KK, COL0, DST, ROW0, NCOLS) { const int nb_ = (NCOLS) / 32, ni_ = ((KK) / 64) * nb_; \
    if (r < ni_) { const int kb_ = r / nb_, nn_ = r % nb_; tr_item((SRC), (LD), 64 * kb_, (COL0) + 32 * nn_, (DST), (KK), (ROW0) + 32 * nn_, scr, lane); continue; } r -= ni_; }

__device__ __forceinline__ void norm_mod_row2(const float* xa, const float* xb, bool hasb, const float* nw, const float* mva, const float* mvb, int shoff, bf16* oa, bf16* ob, int lane) {
    const f32x4* xra = (const f32x4*)xa + lane; const f32x4* xrb = (const f32x4*)(hasb ? xb : xa) + lane;
    f32x4 va[8], vb[8]; float sa = 0.f, sb = 0.f;
#pragma unroll
    for (int j = 0; j < 8; ++j) { va[j] = xra[64 * j]; vb[j] = xrb[64 * j]; }
#pragma unroll
    for (int j = 0; j < 8; ++j) { sa += (va[j].x * va[j].x + va[j].y * va[j].y) + (va[j].z * va[j].z + va[j].w * va[j].w); sb += (vb[j].x * vb[j].x + vb[j].y * vb[j].y) + (vb[j].z * vb[j].z + vb[j].w * vb[j].w); }
    const float ra = rsqrtf(wave_sum(sa) * (1.f / DM) + EPS), rb = rsqrtf(wave_sum(sb) * (1.f / DM) + EPS);
#pragma unroll
    for (int j = 0; j < 8; ++j) { const int idx = 4 * (lane + 64 * j);
        const f32x4 w = *(const f32x4*)(nw + idx);
        { const f32x4 sh = *(const f32x4*)(mva + shoff + idx), sc = *(const f32x4*)(mva + shoff + DM + idx);
          const f32x4 y = (va[j] * ra * w) * (sc + 1.0f) + sh; v2u o; o.x = pk2(y.x, y.y); o.y = pk2(y.z, y.w); *(v2u*)(oa + idx) = o; }
        if (hasb) { const f32x4 sh = *(const f32x4*)(mvb + shoff + idx), sc = *(const f32x4*)(mvb + shoff + DM + idx);
          const f32x4 y = (vb[j] * rb * w) * (sc + 1.0f) + sh; v2u o; o.x = pk2(y.x, y.y); o.y = pk2(y.z, y.w); *(v2u*)(ob + idx) = o; } }
}

#define XB_TMO      128
#define XB_XCNT(j)  (256  + 64 * (j))
#define XB_XSUB(j)  (1280 + 64 * (j))
#define XB_XGEN(j)  (2304 + 64 * (j))
#define XB_TOP      3328
#define XB_TOPGEN   3392
#define XCD_BAR_WORDS 3456
#define XB_SPIN_CAP (1u << 18)

__device__ __forceinline__ unsigned xb_ld(unsigned* p)              { return __hip_atomic_load(p, __ATOMIC_RELAXED, __HIP_MEMORY_SCOPE_AGENT); }
__device__ __forceinline__ unsigned xb_add(unsigned* p, unsigned v) { return __hip_atomic_fetch_add(p, v, __ATOMIC_RELAXED, __HIP_MEMORY_SCOPE_AGENT); }
__device__ __forceinline__ unsigned xb_xcc_id() { return (unsigned)__builtin_amdgcn_s_getreg((3 << 11) | 20) & 0xFu; }
#define XB_SPIN(cond, bar) do { unsigned _sp = 0; while (cond) { __builtin_amdgcn_s_sleep(1); \
    if ((++_sp & 255u) == 0u) { if (xb_ld(&(bar)[XB_TMO])) break; if (_sp > XB_SPIN_CAP) { atomicAdd(&(bar)[XB_TMO], 1u); break; } } } } while (0)

struct XcdBarrier {
    unsigned* bar; unsigned x;
    volatile LAS unsigned* st;
};

__device__ __forceinline__ XcdBarrier xcd_barrier_post(unsigned* bar, volatile LAS unsigned* st) {
    XcdBarrier b; b.bar = bar; b.x = xb_xcc_id(); b.st = st;
    if (threadIdx.x == 0) (void)xb_add(&bar[XB_XCNT(b.x)], 1u);
    return b;
}
__device__ __forceinline__ void xcd_barrier_complete(unsigned* bar, unsigned x, unsigned& nloc, unsigned& nx) {
    const unsigned G = gridDim.x * gridDim.y * gridDim.z;
    unsigned sum, cnt, mine, sp = 0u;
    for (;;) {
        sum = 0u; cnt = 0u; mine = 0u;
#pragma unroll
        for (unsigned j = 0; j < 16; ++j) { const unsigned c = xb_ld(&bar[XB_XCNT(j)]); sum += c; cnt += (c > 0u) ? 1u : 0u; mine = (j == x) ? c : mine; }
        if (sum == G) break;
        __builtin_amdgcn_s_sleep(1);
        if ((++sp & 255u) == 0u) { if (xb_ld(&bar[XB_TMO])) break; if (sp > XB_SPIN_CAP) { atomicAdd(&bar[XB_TMO], 1u); break; } }
    }
    nloc = mine > 0u ? mine : 1u; nx = cnt > 0u ? cnt : 1u;
}

__device__ __forceinline__ void xcd_barrier(const XcdBarrier& b) {
    asm volatile("s_waitcnt vmcnt(0)" ::: "memory");
    __syncthreads();
    if (threadIdx.x == 0) {
        unsigned* bar = b.bar;
        __builtin_amdgcn_s_waitcnt(0);
        unsigned nloc = b.st[0], nx = b.st[1];
        if (nloc == 0u) { xcd_barrier_complete(bar, b.x, nloc, nx); b.st[0] = nloc; b.st[1] = nx; }
        const unsigned old = xb_add(&bar[XB_XSUB(b.x)], 1u);
        const unsigned gen = old / nloc;
        if (old + 1u == (gen + 1u) * nloc) {
            __builtin_amdgcn_fence(__ATOMIC_RELEASE, "agent");
            asm volatile("s_waitcnt vmcnt(0)" ::: "memory");
            const unsigned og = xb_add(&bar[XB_TOP], 1u);
            const unsigned tg = og / nx;
            if (og + 1u == (tg + 1u) * nx) xb_add(&bar[XB_TOPGEN], 1u);
            else XB_SPIN(xb_ld(&bar[XB_TOPGEN]) == tg, bar);
            __builtin_amdgcn_fence(__ATOMIC_ACQUIRE, "agent");
            xb_add(&bar[XB_XGEN(b.x)], 1u);
            asm volatile("s_waitcnt vmcnt(0)" ::: "memory");
        } else {
            XB_SPIN(xb_ld(&bar[XB_XGEN(b.x)]) == gen, bar);
            __builtin_amdgcn_fence(__ATOMIC_ACQUIRE, "agent");
            asm volatile("s_waitcnt vmcnt(0)" ::: "memory");
        }
    }
    __syncthreads();
}

__global__ void __launch_bounds__(NT, 2) mega_fwd(Args args) {
    extern __shared__ __attribute__((aligned(16))) unsigned char lds_raw[];
    LAS unsigned char* lds = (LAS unsigned char*)lds_raw;
    cg::grid_group grid = cg::this_grid();
    const int tid = threadIdx.x, lane = tid & 63, wave = __builtin_amdgcn_readfirstlane(tid >> 6);
    const int G_ = gridDim.x, bid = blockIdx.x;
    const int gw = bid * NW + wave, NGW = G_ * NW;
    const int lo = args.ph_lo, hi = args.ph_hi;
    const bool multi = (hi - lo) > 1;
    unsigned char* ws = args.ws;
    volatile LAS unsigned* xst = (volatile LAS unsigned*)(lds + LDS_BYTES - 16);
    if (tid < 4) xst[tid] = 0u;
    __syncthreads();
    XcdBarrier xb; xb.bar = (unsigned*)(ws + WS_BAR); xb.x = 0; xb.st = xst;
    if (multi && bid == 0) { unsigned* bw = (unsigned*)(ws + WS_BAR); for (int i = tid; i < XCD_BAR_WORDS; i += NT) bw[i] = 0u; }
#ifndef MK_RPT
#define MK_RPT 0
#endif
#define RPT(k) ((MK_RPT >> (k)) & 1)
#define IN(k) (lo <= (k) && (k) < hi)
#define SEAM(k) do { if (multi && IN((k) + 1)) { if ((k) == 0) { grid.sync(); xb = xcd_barrier_post((unsigned*)(ws + WS_BAR), xst); } else xcd_barrier(xb); } } while (0)

    const float* x = args.in[0]; const float* cvec = args.in[1]; const float* ctx = args.in[2]; const float* c_ctx = args.in[3];
    const float* w_ada = args.in[4]; const float* b_ada = args.in[5]; const float* norm1_w = args.in[6]; const float* w_in = args.in[7];
    const float* w_a_up_f = args.in[8]; const float* b_a_f = args.in[9]; const float* w_a_up_b = args.in[10]; const float* b_a_b = args.in[11];
    const float* gla_onorm_w = args.in[12]; const float* qnorm_w = args.in[13]; const float* knorm_w = args.in[14];
    const float* diff_onorm_w = args.in[19]; const float* w_proj_gla = args.in[20]; const float* w_proj_diff = args.in[21];
    const float* w_gate = args.in[22]; const float* b_gate = args.in[23]; const float* w_out = args.in[24]; const float* norm2_w = args.in[25];
    const float* w_up = args.in[26]; const float* conv_w = args.in[27]; const float* conv_b = args.in[28]; const float* w_down = args.in[29];
    float* out = args.out;
    float* MOD = (float*)(ws + WS_MOD); float* LAMP = (float*)(ws + WS_LAM);
    bf16* WCAT = (bf16*)(ws + WS_WCAT); bf16* WPG = (bf16*)(ws + WS_WPG); bf16* WPD = (bf16*)(ws + WS_WPD); bf16* WO = (bf16*)(ws + WS_WO);
    bf16* WUP = (bf16*)(ws + WS_WUP); bf16* WDN = (bf16*)(ws + WS_WDN);
    bf16* H = (bf16*)(ws + WS_H); bf16* H2 = (bf16*)(ws + WS_H2); bf16* ACT1 = (bf16*)(ws + WS_ACT1); bf16* GB = (bf16*)(ws + WS_G);
    float* LR = (float*)(ws + WS_LR); float* GDEC = (float*)(ws + WS_GDEC); float* UB = (float*)(ws + WS_U); bf16* SB = (bf16*)(ws + WS_S);
    bf16* YA = (bf16*)(ws + WS_YA); bf16* YB = (bf16*)(ws + WS_YB); float* T1 = (float*)(ws + WS_T1); bf16* MRG = (bf16*)(ws + WS_MRG);
    bf16* U2 = (bf16*)(ws + WS_U2); bf16* ACT2 = (bf16*)(ws + WS_ACT2);

    if (IN(0)) { for (int rep_ = 0; rep_ <= RPT(0); ++rep_) {
        {
            LAS float* sc = (LAS float*)lds; LAS float* red = sc + 3 * DM;
            for (int i = tid; i < 3 * DM; i += NT) { const int v = i / DM, k = i % DM; const float s = v < 2 ? cvec[v * DM + k] : c_ctx[k]; sc[i] = siluf_(s); }
            __syncthreads();
            const int cl = tid % 12, rl = tid / 12;
            for (int cb = bid; cb < 256; cb += G_) {
                f32x4 a0 = {0.f, 0.f, 0.f, 0.f}, a1 = a0, a2 = a0;
                if (tid < 504) {
                    const float* wp = w_ada + 48 * cb + 4 * cl;
                    for (int k = rl; k < DM; k += 42) { const f32x4 w = *(const f32x4*)(wp + (size_t)k * 12288); a0 += w * sc[k]; a1 += w * sc[DM + k]; a2 += w * sc[2 * DM + k]; }
                    LAS float* rp = red + (rl * 12 + cl) * 12;
#pragma unroll
                    for (int e = 0; e < 4; ++e) { rp[e] = a0[e]; rp[4 + e] = a1[e]; rp[8 + e] = a2[e]; }
                }
                __syncthreads();
                if (tid < 144) { const int cl2 = tid / 12, ve = tid % 12, v = ve >> 2, e = ve & 3; float s = 0.f;
                    for (int r2 = 0; r2 < 42; ++r2) s += red[(r2 * 12 + cl2) * 12 + ve];
                    const int n = 48 * cb + 4 * cl2 + e; MOD[v * 12288 + n] = s + b_ada[n]; }
                __syncthreads();
            }
            if (bid == 1 % G_) { float* tabg = (float*)(ws + WS_TAB);
                for (int i = tid; i < 1024; i += NT) { const int pos_ = i >> 4, f = i & 15;
                    const float invf = exp2f(-(float)f * (13.287712379549449f / 16.f));
                    float sn, cs; sincosf((float)pos_ * invf, &sn, &cs); tabg[2 * i] = cs; tabg[2 * i + 1] = sn; } }
            if (bid == 0 && tid == 0) { float s1 = 0.f, s2 = 0.f;
                for (int i = 0; i < 64; ++i) { s1 += args.in[15][i] * args.in[16][i]; s2 += args.in[17][i] * args.in[18][i]; }
                LAMP[0] = expf(s1) - expf(s2) + LAM_INIT; }
        }
        {
            LAS float* scr = (LAS float*)(lds + wave * 16384);
            constexpr int NITEMS = 2 * 32 * 96 + 32 * 128 + 32 * 1 + 2 * 16 * 64 + 32 * 64;
            for (int it = gw; it < NITEMS; it += NGW) {
                int r = it;
                TRJOB(w_in, DIN, 2048, 0, WCAT, 0, 3072)
                TRJOB(w_in, DIN, 2048, 3104, WCAT, 3072, 3072)
                TRJOB(w_gate, 4096, 2048, 0, WCAT, 6144, 4096)
                TRJOB(w_in, DIN, 2048, 3072, WCAT, 10240, 32)
                TRJOB2(w_proj_gla, 2048, 1024, 0, WPG, 2048, 0, 0, 2048)
                TRJOB2(w_proj_diff, 2048, 1024, 0, WPG, 2048, 1024, 0, 2048)
                TRJOB(w_out, 2048, 2048, 0, WO, 0, 2048)
            }
            v4u* z = (v4u*)(WCAT + (size_t)10272 * 2048);
            for (int i = bid * NT + tid; i < 224 * 2048 / 8; i += G_ * NT) z[i] = (v4u){0u, 0u, 0u, 0u};
        }
        __syncthreads(); }
        SEAM(0);
    }

    if (IN(1)) { for (int rep_ = 0; rep_ <= RPT(1); ++rep_) {
        for (int r = gw; r < MT; r += 2 * NGW) {
            const int r2 = r + NGW; const bool hb = r2 < MT; const int rb = hb ? r2 : r;
            const float* sa = r < ML ? x + (size_t)r * DM : ctx + (size_t)(r - ML) * DM;
            const float* sb = rb < ML ? x + (size_t)rb * DM : ctx + (size_t)(rb - ML) * DM;
            norm_mod_row2(sa, sb, hb, norm1_w, MOD + (size_t)(r < ML ? r / SEQ : 2) * 12288, MOD + (size_t)(rb < ML ? rb / SEQ : 2) * 12288, 0, H + (size_t)r * DM, H + (size_t)rb * DM, lane);
        }
        __syncthreads(); }
        SEAM(1);
    }

    if (IN(2)) { for (int rep_ = 0; rep_ <= RPT(2); ++rep_) {
        pg8::Gemm g{H, WCAT, MT, NCAT, DM}; pg8::StaticOrder S; S.init(MT, NCAT, G_, bid);
        epi::EpiP2 E{ACT1, GB, LR, b_gate};
        pg8::gemm_phase<epi::EpiP2, pg8::StaticOrder, true, true>(lds, g, S, E);
        {
            const int nun = (MT / 256) * (NCAT / 256), rounds = (nun + G_ - 1) / G_, nlast = nun - (rounds - 1) * G_;
            int nidle = G_ - nlast, j = bid - nlast;
            if (nidle == 0) { nidle = G_; j = bid; }
            if (j >= 0) {
                LAS float* scr = (LAS float*)(lds + wave * 16384);
                for (int it = j * NW + wave; it < 32 * 352 + 88 * 64; it += nidle * NW) {
                    if (it < 32 * 352) { const int kb = it / 352, nb = it % 352, row0 = 32 * nb, T = row0 >> 8, rr = row0 & 255;
                        const int col0 = rr < 128 ? 128 * T + rr : DFF + 128 * T + (rr - 128);
                        tr_item(w_up, NUP, 64 * kb, col0, WUP, 2048, row0, scr, lane); }
                    else { const int r = it - 32 * 352, kb = r / 64, nb = r % 64; tr_item(w_down, 2048, 64 * kb, 32 * nb, WDN, DFF, 32 * nb, scr, lane); } }
            }
        }
        __syncthreads(); }
        SEAM(2);
    }

    if (IN(3)) { for (int rep_ = 0; rep_ <= RPT(3); ++rep_) {
        {
            const float* tab = (const float*)(ws + WS_TAB);
            const int nheavy = (NITEM1 > NGW && NITEM1 - NGW < NGW) ? NITEM1 - NGW : 0;
            const int rw = gw - nheavy, nrw = NGW - nheavy;
            const int l8 = lane & 7;
            const bool lower = ((l8 >> 1) & 1) == 0;
            if (rw >= 0) for (int wi0 = rw; wi0 < MT * 4; wi0 += 2 * nrw) {
                v4u raw[2]; bool ok[2]; bf16* ptr[2];
#pragma unroll
                for (int u = 0; u < 2; ++u) { const int wi = wi0 + u * nrw, r = wi >> 2, gi = 8 * (wi & 3) + (lane >> 3);
                    ok[u] = (wi < MT * 4) && !(r >= ML && gi < 16);
                    ptr[u] = ACT1 + (size_t)(ok[u] ? r : 0) * NACT + 3072 + 64 * gi + 8 * l8;
                    raw[u] = ok[u] ? *(const v4u*)ptr[u] : (v4u){0u, 0u, 0u, 0u}; }
#pragma unroll
                for (int u = 0; u < 2; ++u) {
                    if (!ok[u]) continue;
                    const int wi = wi0 + u * nrw, r = wi >> 2, gi = 8 * (wi & 3) + (lane >> 3);
                    const bool isq = gi < 16;
                    float y[8] = {bflo(raw[u].x), bfhi(raw[u].x), bflo(raw[u].y), bfhi(raw[u].y), bflo(raw[u].z), bfhi(raw[u].z), bflo(raw[u].w), bfhi(raw[u].w)};
                    float ss = 0.f;
#pragma unroll
                    for (int e = 0; e < 8; ++e) ss += y[e] * y[e];
                    ss += __shfl_xor(ss, 1); ss += __shfl_xor(ss, 2); ss += __shfl_xor(ss, 4);
                    const float rs = rsqrtf(ss * (1.f / 64.f) + EPS);
                    const float* nwp = (isq ? qnorm_w : knorm_w) + 8 * l8;
#pragma unroll
                    for (int e = 0; e < 8; ++e) y[e] = y[e] * rs * nwp[e];
                    if (r < ML) {
                        const int t = r & (SEQ - 1); const int pos_ = (l8 < 4) ? (t >> 6) : (t & 63);
                        const float qs = isq ? 0.125f * 1.4426950408889634f : 1.0f;
                        const float* tp = tab + 2 * (pos_ * 16 + 8 * (l8 & 1));
#pragma unroll
                        for (int e = 0; e < 8; ++e) {
                            const float yp = __shfl_xor(y[e], 2);
                            const float cs = tp[2 * e], sn = tp[2 * e + 1];
                            y[e] = (lower ? (y[e] * cs - yp * sn) : (y[e] * cs + yp * sn)) * qs;
                        }
                    }
                    v4u o; o.x = pk2(y[0], y[1]); o.y = pk2(y[2], y[3]); o.z = pk2(y[4], y[5]); o.w = pk2(y[6], y[7]);
                    *(v4u*)ptr[u] = o;
                }
            }
        }
        {
            LAS unsigned char* wl = lds + wave * 18176;
            LAS float* tot = (LAS float*)(wl + 17920);
            const int l31 = lane & 31, hh = lane >> 5, qq = (lane & 15) >> 2, pp = lane & 3, blk = (lane >> 4) & 1;
            for (int item = gw; item < NITEM1; item += NGW) {
                const int c = item % 68, chain = item / 68, dir = chain & 1, bh = chain >> 1, h = bh & 7, b = bh >> 3;
                const int R0 = (c < 4) ? ML + 256 * b + (dir ? 192 - 64 * c : 64 * c) : SEQ * b + (dir ? SEQ - 64 * (c - 3) : 64 * (c - 4));
                const float* wup = (dir ? w_a_up_b : w_a_up_f) + 64 * h + lane;
                const float bias = (dir ? b_a_b : b_a_f)[64 * h + lane];
                int lri[16];
#pragma unroll
                for (int q4 = 0; q4 < 4; ++q4) { const f32x4 t_ = *(const f32x4*)(LR + (size_t)(R0 + lane) * 32 + 16 * dir + 4 * q4);
                    lri[4 * q4] = __float_as_int(t_.x); lri[4 * q4 + 1] = __float_as_int(t_.y); lri[4 * q4 + 2] = __float_as_int(t_.z); lri[4 * q4 + 3] = __float_as_int(t_.w); }
                float wu[16];
#pragma unroll
                for (int r2 = 0; r2 < 16; ++r2) wu[r2] = wup[r2 * 512];
                { const bf16* kp = ACT1 + (size_t)(R0 + lane) * NACT + 512 + 64 * h;
#pragma unroll
                  for (int c8 = 0; c8 < 8; ++c8) *(LAS v4u*)(wl + lane * 144 + 16 * c8) = *(const v4u*)(kp + 8 * c8); }
                LDS_WAIT(); asm volatile("" ::: "memory");
                float bsum = 0.f;
                for (int p = 0; p < 64; ++p) {
                    const int rho = dir ? 63 - p : p;
                    float z = bias;
#pragma unroll
                    for (int r2 = 0; r2 < 16; ++r2) z += __int_as_float(__builtin_amdgcn_readlane(lri[r2], rho)) * wu[r2];
                    bsum += logsigf_(z) * (1.f / 16.f);
                    LAS bf16* kq = (LAS bf16*)(wl + rho * 144) + lane;
                    *kq = (bf16)f2bf(bf2f(*kq) * __expf(-bsum));
                }
                const float et = __expf(bsum);
                tot[lane] = et; GDEC[(size_t)item * 64 + lane] = et;
#pragma unroll 1
                for (int eh = 0; eh < 2; ++eh) {
                    { const bf16* vp = ACT1 + (size_t)R0 * NACT + 1024 + 128 * h + 64 * eh;
#pragma unroll
                      for (int k2 = 0; k2 < 8; ++k2) { const int idx = lane + 64 * k2, row = idx >> 3, c8 = idx & 7;
                        const v4u t = *(const v4u*)(vp + (size_t)row * NACT + 8 * c8);
                        LAS unsigned char* dp = wl + 9216 + row * 136 + 16 * c8; *(LAS v2u*)dp = (v2u){t.x, t.y}; *(LAS v2u*)(dp + 8) = (v2u){t.z, t.w}; } }
                    LDS_WAIT(); asm volatile("" ::: "memory");
#pragma unroll
                    for (int db = 0; db < 2; ++db)
#pragma unroll
                        for (int eb = 0; eb < 2; ++eb) {
                            f32x16 acc;
#pragma unroll
                            for (int i = 0; i < 16; ++i) acc[i] = 0.f;
#pragma unroll
                            for (int s = 0; s < 4; ++s) {
                                const LAS unsigned char* ap = wl + (16 * s + 4 * hh + qq) * 144 + 64 * db + 32 * blk + 8 * pp;
                                const LAS unsigned char* bp = wl + 9216 + (16 * s + 4 * hh + qq) * 136 + 64 * eb + 32 * blk + 8 * pp;
                                const s16x4 alo = __builtin_bit_cast(s16x4, __builtin_amdgcn_ds_read_tr16_b64_v4i16((LAS v4i16_t*)ap));
                                const s16x4 ahi = __builtin_bit_cast(s16x4, __builtin_amdgcn_ds_read_tr16_b64_v4i16((LAS v4i16_t*)(ap + 8 * 144)));
                                const s16x4 blo = __builtin_bit_cast(s16x4, __builtin_amdgcn_ds_read_tr16_b64_v4i16((LAS v4i16_t*)bp));
                                const s16x4 bhi = __builtin_bit_cast(s16x4, __builtin_amdgcn_ds_read_tr16_b64_v4i16((LAS v4i16_t*)(bp + 8 * 136)));
                                acc = MFMA32(__builtin_shufflevector(alo, ahi, 0, 1, 2, 3, 4, 5, 6, 7), __builtin_shufflevector(blo, bhi, 0, 1, 2, 3, 4, 5, 6, 7), acc);
                            }
                            float* up = UB + (size_t)item * 8192 + (size_t)(64 * eh + 32 * eb + l31) * 64 + 32 * db + 4 * hh;
#pragma unroll
                            for (int g4 = 0; g4 < 4; ++g4) { const f32x4 t = *(const LAS f32x4*)(tot + 32 * db + 8 * g4 + 4 * hh);
                                *(f32x4*)(up + 8 * g4) = (f32x4){acc[4 * g4] * t.x, acc[4 * g4 + 1] * t.y, acc[4 * g4 + 2] * t.z, acc[4 * g4 + 3] * t.w}; }
                        }
                    LDS_WAIT(); asm volatile("" ::: "memory");
                }
            }
        }
        __syncthreads(); }
        SEAM(3);
    }

    if (IN(4)) { for (int rep_ = 0; rep_ <= RPT(4); ++rep_) {
        {
            typedef float f32x2_ __attribute__((ext_vector_type(2)));
            for (int ti = bid * NT + tid; ti < 131072; ti += G_ * NT) {
                const int chain = ti >> 12, el = ti & 4095, e = el >> 5, d2 = (el & 31) * 2;
                f32x2_ sv = {0.f, 0.f};
                const float* up = UB + (size_t)chain * 68 * 8192 + e * 64 + d2; const float* gp = GDEC + (size_t)chain * 68 * 64 + d2;
                bf16* sp = SB + (size_t)chain * 64 * 8192 + e * 64 + d2;
#pragma unroll 1
                for (int c0 = 0; c0 < 68; c0 += 17) {
                    f32x2_ uu[17], gg[17];
#pragma unroll
                    for (int j = 0; j < 17; ++j) { uu[j] = *(const f32x2_*)(up + (size_t)(c0 + j) * 8192); gg[j] = *(const f32x2_*)(gp + (c0 + j) * 64); }
#pragma unroll
                    for (int j = 0; j < 17; ++j) { const int c = c0 + j;
                        if (c >= 4) *(unsigned*)(sp + (size_t)(c - 4) * 8192) = pk2(sv.x, sv.y);
                        sv = gg[j] * sv + uu[j]; }
                }
            }
        }
        {
            const float lam = LAMP[0];
            float kbound; { float wmx = fabsf(knorm_w[lane]);
#pragma unroll
                for (int o = 1; o < 64; o <<= 1) wmx = fmaxf(wmx, __shfl_xor(wmx, o));
                kbound = 8.f * wmx * 1.01f; }
            const int mp = wave >> 2, qw = wave & 3, l31 = lane & 31, hh = lane >> 5;
            const int qq = (lane & 15) >> 2, pp = lane & 3, blk = (lane >> 4) & 1;
            constexpr int KP = 272, VP = 320, STG = 64 * KP + 64 * VP;
            for (int un = bid; un < 512; un += G_) {
                const int b = un >> 8, h = (un >> 5) & 7, qb = un & 31;
                const int Rq = SEQ * b + 128 * qb + 32 * qw + l31;
                bf16x8 qf[4];
#pragma unroll
                for (int ks = 0; ks < 4; ++ks) qf[ks] = *(const bf16x8*)(ACT1 + (size_t)Rq * NACT + 3072 + 128 * h + 64 * mp + 16 * ks + 8 * hh);
                f32x16 O[4];
#pragma unroll
                for (int eb = 0; eb < 4; ++eb)
#pragma unroll
                    for (int i = 0; i < 16; ++i) O[eb][i] = 0.f;
                float negm; float lsum = 0.f;
                { float qn2 = 0.f;
#pragma unroll
                  for (int ks = 0; ks < 4; ++ks)
#pragma unroll
                      for (int j = 0; j < 8; ++j) { const float qv = bf2f((unsigned short)qf[ks][j]); qn2 += qv * qv; }
                  qn2 += __shfl_xor(qn2, 32);
                  negm = -sqrtf(qn2) * kbound; }
                const int srow0 = tid >> 4, sc16 = tid & 15;
                v4u stK[2], stV[2];
#define ATT_LOAD(kt) do { const int krow0_ = (kt) < 4 ? ML + 256 * b + 64 * (kt) : SEQ * b + 64 * ((kt) - 4); \
                    _Pragma("unroll") for (int p = 0; p < 2; ++p) { const bf16* src_ = ACT1 + (size_t)(krow0_ + srow0 + 32 * p) * NACT + 128 * h + 8 * sc16; \
                        stK[p] = *(const v4u*)(src_ + 4096); stV[p] = *(const v4u*)(src_ + 5120); } } while (0)
#define ATT_STORE(stg) do { _Pragma("unroll") for (int p = 0; p < 2; ++p) { LAS unsigned char* d_ = lds + (stg) * STG + (srow0 + 32 * p) * KP + 16 * sc16; \
                        *(LAS v4u*)d_ = stK[p]; *(LAS v4u*)(lds + (stg) * STG + 64 * KP + (srow0 + 32 * p) * VP + 16 * sc16) = stV[p]; } } while (0)
                ATT_LOAD(0); ATT_STORE(0);
                __syncthreads();
                for (int kt = 0; kt < 68; ++kt) {
                    if (kt + 1 < 68) ATT_LOAD(kt + 1);
                    const LAS unsigned char* Kb = lds + (kt & 1) * STG; const LAS unsigned char* Vb = Kb + 64 * KP;
                    f32x16 X[2];
#pragma unroll
                    for (int t2 = 0; t2 < 2; ++t2) {
#pragma unroll
                        for (int i = 0; i < 16; ++i) X[t2][i] = 0.f;
#pragma unroll
                        for (int ks = 0; ks < 4; ++ks) { const bf16x8 kf = *(const LAS bf16x8*)(Kb + (32 * t2 + l31) * KP + 2 * (64 * mp + 16 * ks + 8 * hh)); X[t2] = MFMA32(kf, qf[ks], X[t2]); }
                    }
                    float ps = 0.f;
#pragma unroll
                    for (int t2 = 0; t2 < 2; ++t2)
#pragma unroll
                        for (int i = 0; i < 16; ++i) { const float p = __builtin_amdgcn_exp2f(X[t2][i] + negm); X[t2][i] = p; ps += p; }
                    lsum += ps;
#pragma unroll
                    for (int t2 = 0; t2 < 2; ++t2)
#pragma unroll
                        for (int s = 0; s < 2; ++s) {
                            v4u pk; pk.x = pk2(X[t2][8 * s + 0], X[t2][8 * s + 1]); pk.y = pk2(X[t2][8 * s + 2], X[t2][8 * s + 3]);
                            pk.z = pk2(X[t2][8 * s + 4], X[t2][8 * s + 5]); pk.w = pk2(X[t2][8 * s + 6], X[t2][8 * s + 7]);
                            const bf16x8 pf = __builtin_bit_cast(bf16x8, pk);
                            const LAS unsigned char* vrow = Vb + (32 * t2 + 16 * s + 4 * hh + qq) * VP + 32 * blk + 8 * pp;
#pragma unroll
                            for (int eb = 0; eb < 4; ++eb) {
                                const s16x4 vlo = __builtin_bit_cast(s16x4, __builtin_amdgcn_ds_read_tr16_b64_v4i16((LAS v4i16_t*)(vrow + 64 * eb)));
                                const s16x4 vhi = __builtin_bit_cast(s16x4, __builtin_amdgcn_ds_read_tr16_b64_v4i16((LAS v4i16_t*)(vrow + 8 * VP + 64 * eb)));
                                const bf16x8 vf = __builtin_shufflevector(vlo, vhi, 0, 1, 2, 3, 4, 5, 6, 7);
                                O[eb] = MFMA32(vf, pf, O[eb]);
                            }
                        }
                    if (kt + 1 < 68) ATT_STORE((kt + 1) & 1);
                    __syncthreads();
                }
#undef ATT_LOAD
#undef ATT_STORE
                lsum += __shfl_xor(lsum, 32);
                const float inv = 1.f / lsum;
                LAS float* ob = (LAS float*)lds;
                if (mp == 1) {
                    const float sc = inv * lam;
#pragma unroll
                    for (int eb = 0; eb < 4; ++eb)
#pragma unroll
                        for (int i = 0; i < 16; ++i) ob[(32 * qw + l31) * 132 + 32 * eb + crow(i, hh)] = O[eb][i] * sc;
                }
                __syncthreads();
                if (mp == 0) {
                    float ss = 0.f;
#pragma unroll
                    for (int eb = 0; eb < 4; ++eb)
#pragma unroll
                        for (int i = 0; i < 16; ++i) { const float v = O[eb][i] * inv - ob[(32 * qw + l31) * 132 + 32 * eb + crow(i, hh)]; O[eb][i] = v; ss += v * v; }
                    ss += __shfl_xor(ss, 32);
                    const float rs = rsqrtf(ss * (1.f / 128.f) + EPS) * (1.f - LAM_INIT);
                    bf16* yp = YA + (size_t)Rq * 2048 + 1024 + 128 * h;
#pragma unroll
                    for (int eb = 0; eb < 4; ++eb)
#pragma unroll
                        for (int g4 = 0; g4 < 4; ++g4) { const int e0 = 32 * eb + 8 * g4 + 4 * hh; const f32x4 w = *(const f32x4*)(diff_onorm_w + e0);
                            v2u o; o.x = pk2(O[eb][4 * g4 + 0] * rs * w.x, O[eb][4 * g4 + 1] * rs * w.y); o.y = pk2(O[eb][4 * g4 + 2] * rs * w.z, O[eb][4 * g4 + 3] * rs * w.w);
                            *(v2u*)(yp + e0) = o; }
                }
                __syncthreads();
            }
        }
        __syncthreads(); }
        SEAM(4);
    }

    if (IN(5)) { for (int rep_ = 0; rep_ <= RPT(5); ++rep_) {
        const int g = tid >> 8, gwv = wave & 3, gt = tid & 255;
        LAS unsigned char* gl = lds + g * 55808;
        LAS float* xch = (LAS float*)(gl + 53248);
        const int l31 = lane & 31, hh = lane >> 5, qq = (lane & 15) >> 2, pp = lane & 3, blk = (lane >> 4) & 1;
        const int ib = gwv & 1, eh = gwv >> 1, itok = 32 * ib + l31;
        for (int pi = bid; pi < 512; pi += G_) {
            const int item = 2 * pi + g, m = item & 63, bh = item >> 6, h = bh & 7, b = bh >> 3, R0 = SEQ * b + 64 * m;
            bf16x8 Sfr[2][8]; v2u rr[2][4];
#pragma unroll
            for (int eb = 0; eb < 2; ++eb) {
#pragma unroll
                for (int ks = 0; ks < 8; ++ks) { const int dir = ks >> 2;
                    Sfr[eb][ks] = *(const bf16x8*)(SB + ((size_t)(bh * 2 + dir) * 64 + (dir ? 63 - m : m)) * 8192 + (size_t)(64 * eh + 32 * eb + l31) * 64 + 16 * (ks & 3) + 8 * hh); }
#pragma unroll
                for (int g4 = 0; g4 < 4; ++g4) rr[eb][g4] = *(const v2u*)(ACT1 + (size_t)(R0 + itok) * NACT + 2048 + 128 * h + 64 * eh + 32 * eb + 8 * g4 + 4 * hh);
            }
            {
                const int rw0 = 16 * gwv;
                float wuf[16], wub[16];
#pragma unroll
                for (int r2 = 0; r2 < 16; ++r2) { wuf[r2] = w_a_up_f[r2 * 512 + 64 * h + lane]; wub[r2] = w_a_up_b[r2 * 512 + 64 * h + lane]; }
                const float biasf = b_a_f[64 * h + lane], biasb = b_a_b[64 * h + lane];
                int lri[32];
#pragma unroll
                for (int q4 = 0; q4 < 8; ++q4) { const f32x4 t_ = *(const f32x4*)(LR + (size_t)(R0 + rw0 + (lane & 15)) * 32 + 4 * q4);
                    lri[4 * q4] = __float_as_int(t_.x); lri[4 * q4 + 1] = __float_as_int(t_.y); lri[4 * q4 + 2] = __float_as_int(t_.z); lri[4 * q4 + 3] = __float_as_int(t_.w); }
                unsigned short qraw[16], kraw[16];
                { const bf16* qp = ACT1 + (size_t)(R0 + rw0) * NACT + 64 * h + lane;
#pragma unroll
                  for (int i = 0; i < 16; ++i) { qraw[i] = qp[(size_t)i * NACT]; kraw[i] = qp[(size_t)i * NACT + 512]; } }
                { const bf16* vp = ACT1 + (size_t)(R0 + rw0) * NACT + 1024 + 128 * h;
#pragma unroll
                  for (int k2 = 0; k2 < 4; ++k2) { const int idx = lane + 64 * k2, row = idx >> 4, c16 = idx & 15;
                    *(LAS v4u*)(gl + 35840 + (rw0 + row) * 272 + 16 * c16) = *(const v4u*)(vp + (size_t)row * NACT + 8 * c16); } }
                float cf[16], cb[16];
#pragma unroll
                for (int i = 0; i < 16; ++i) { float zf = biasf, zb = biasb;
#pragma unroll
                    for (int r2 = 0; r2 < 16; ++r2) { zf += __int_as_float(__builtin_amdgcn_readlane(lri[r2], i)) * wuf[r2]; zb += __int_as_float(__builtin_amdgcn_readlane(lri[16 + r2], i)) * wub[r2]; }
                    cf[i] = logsigf_(zf) * (1.f / 16.f); cb[i] = logsigf_(zb) * (1.f / 16.f); }
#pragma unroll
                for (int i = 1; i < 16; ++i) cf[i] += cf[i - 1];
#pragma unroll
                for (int i = 14; i >= 0; --i) cb[i] += cb[i + 1];
                LAS float* segp = (LAS float*)(gl + 53248 + 512);
                segp[gwv * 64 + lane] = cf[15]; segp[256 + gwv * 64 + lane] = cb[0];
                __syncthreads();
                float offf = 0.f, offb = 0.f;
#pragma unroll
                for (int w2 = 0; w2 < 4; ++w2) { if (w2 < gwv) offf += segp[w2 * 64 + lane]; if (w2 > gwv) offb += segp[256 + w2 * 64 + lane]; }
#pragma unroll
                for (int i = 0; i < 16; ++i) { const int rho = rw0 + i;
                    const float ef = __expf(offf + cf[i]), eb_ = __expf(offb + cb[i]); const float qv = bf2f(qraw[i]), kv = bf2f(kraw[i]);
                    LAS bf16* qe = (LAS bf16*)(gl + rho * 272) + lane; LAS bf16* ke = (LAS bf16*)(gl + 17408 + rho * 144) + lane;
                    qe[0] = (bf16)f2bf(qv * ef); qe[64] = (bf16)f2bf(qv * eb_);
                    ke[0] = (bf16)f2bf(kv * __builtin_amdgcn_rcpf(ef)); ke[4608] = (bf16)f2bf(kv * __builtin_amdgcn_rcpf(eb_)); }
            }
            __syncthreads();
            bf16x8 qf[8];
#pragma unroll
            for (int ks = 0; ks < 8; ++ks) qf[ks] = *(const LAS bf16x8*)(gl + itok * 272 + 2 * (16 * ks + 8 * hh));
            bf16x8 pf[2][2];
#pragma unroll
            for (int jb = 0; jb < 2; ++jb) {
                f32x16 Xf, Xb;
#pragma unroll
                for (int i = 0; i < 16; ++i) { Xf[i] = 0.f; Xb[i] = 0.f; }
                if (jb <= ib) {
#pragma unroll
                    for (int ks = 0; ks < 4; ++ks) { const bf16x8 kf = *(const LAS bf16x8*)(gl + 17408 + (32 * jb + l31) * 144 + 2 * (16 * ks + 8 * hh)); Xf = MFMA32(kf, qf[ks], Xf); } }
                if (jb >= ib) {
#pragma unroll
                    for (int ks = 0; ks < 4; ++ks) { const bf16x8 kb = *(const LAS bf16x8*)(gl + 26624 + (32 * jb + l31) * 144 + 2 * (16 * ks + 8 * hh)); Xb = MFMA32(kb, qf[4 + ks], Xb); } }
                float pv[16];
#pragma unroll
                for (int r2 = 0; r2 < 16; ++r2) { const int j = 32 * jb + crow(r2, hh); pv[r2] = ((j <= itok) ? Xf[r2] : 0.f) + ((j >= itok) ? Xb[r2] : 0.f); }
#pragma unroll
                for (int s = 0; s < 2; ++s) { v4u pk; pk.x = pk2(pv[8 * s], pv[8 * s + 1]); pk.y = pk2(pv[8 * s + 2], pv[8 * s + 3]); pk.z = pk2(pv[8 * s + 4], pv[8 * s + 5]); pk.w = pk2(pv[8 * s + 6], pv[8 * s + 7]);
                    pf[jb][s] = __builtin_bit_cast(bf16x8, pk); }
            }
            f32x16 O[2]; float ss = 0.f;
#pragma unroll
            for (int eb = 0; eb < 2; ++eb) {
                f32x16 acc;
#pragma unroll
                for (int i = 0; i < 16; ++i) acc[i] = 0.f;
#pragma unroll
                for (int ks = 0; ks < 8; ++ks) acc = MFMA32(Sfr[eb][ks], qf[ks], acc);
#pragma unroll
                for (int jb = 0; jb < 2; ++jb)
#pragma unroll
                    for (int s = 0; s < 2; ++s) {
                        const LAS unsigned char* vp = gl + 35840 + (32 * jb + 16 * s + 4 * hh + qq) * 272 + 2 * (64 * eh + 32 * eb) + 32 * blk + 8 * pp;
                        const s16x4 vlo = __builtin_bit_cast(s16x4, __builtin_amdgcn_ds_read_tr16_b64_v4i16((LAS v4i16_t*)vp));
                        const s16x4 vhi = __builtin_bit_cast(s16x4, __builtin_amdgcn_ds_read_tr16_b64_v4i16((LAS v4i16_t*)(vp + 8 * 272)));
                        acc = MFMA32(__builtin_shufflevector(vlo, vhi, 0, 1, 2, 3, 4, 5, 6, 7), pf[jb][s], acc);
                    }
                O[eb] = acc;
#pragma unroll
                for (int i = 0; i < 16; ++i) ss += acc[i] * acc[i];
            }
            ss += __shfl_xor(ss, 32);
            if (hh == 0) xch[gwv * 32 + l31] = ss;
            __syncthreads();
            const float rs = rsqrtf((ss + xch[(gwv ^ 2) * 32 + l31]) * (1.f / 128.f) + EPS);
            bf16* yp = YA + (size_t)(R0 + itok) * 2048 + 128 * h + 64 * eh + 4 * hh;
#pragma unroll
            for (int eb = 0; eb < 2; ++eb)
#pragma unroll
                for (int g4 = 0; g4 < 4; ++g4) { const int e0 = 64 * eh + 32 * eb + 8 * g4 + 4 * hh; const f32x4 w = *(const f32x4*)(gla_onorm_w + e0); const v2u r_ = rr[eb][g4];
                    v2u o; o.x = pk2(O[eb][4 * g4] * rs * w.x * siluf_(bflo(r_.x)), O[eb][4 * g4 + 1] * rs * w.y * siluf_(bfhi(r_.x)));
                    o.y = pk2(O[eb][4 * g4 + 2] * rs * w.z * siluf_(bflo(r_.y)), O[eb][4 * g4 + 3] * rs * w.w * siluf_(bfhi(r_.y)));
                    *(v2u*)(yp + 32 * eb + 8 * g4) = o; }
        }
        __syncthreads(); }
        SEAM(5);
    }

    if (IN(6)) { for (int rep_ = 0; rep_ <= RPT(6); ++rep_) {
        pg8::Gemm g{YA, WPG, ML, DM, DM}; pg8::StaticOrder S; S.init(ML, DM, G_, bid);
        epi::EpiMrg2 E{GB, MRG};
        pg8::gemm_phase<epi::EpiMrg2, pg8::StaticOrder, false, true>(lds, g, S, E);
        __syncthreads(); }
        SEAM(6);
    }

    if (IN(7)) { for (int rep_ = 0; rep_ <= RPT(7); ++rep_) {
        pg8::Gemm g{MRG, WO, ML, DM, DM}; pg8::StaticOrder S; S.init(ML, DM, G_, bid);
        epi::EpiRes E{x, out, MOD + 2 * DM};
        pg8::gemm_phase<epi::EpiRes, pg8::StaticOrder, false, true>(lds, g, S, E);
        __syncthreads(); }
        SEAM(7);
    }

    if (IN(8)) { for (int rep_ = 0; rep_ <= RPT(8); ++rep_) {
        for (int r = gw; r < ML; r += 2 * NGW) {
            const int r2 = r + NGW; const bool hb = r2 < ML; const int rb = hb ? r2 : r;
            norm_mod_row2(out + (size_t)r * DM, out + (size_t)rb * DM, hb, norm2_w, MOD + (size_t)(r / SEQ) * 12288, MOD + (size_t)(rb / SEQ) * 12288, 3 * DM, H2 + (size_t)r * DM, H2 + (size_t)rb * DM, lane);
        }
        __syncthreads(); }
        SEAM(8);
    }

    if (IN(9)) { for (int rep_ = 0; rep_ <= RPT(9); ++rep_) {
        pg8::Gemm g{H2, WUP, 34 * 256, NUP, DM}; pg8::StaticOrder S; S.init(34 * 256, NUP, G_, bid); S.conv = 1;
        epi::EpiConv E{ACT2, conv_w, conv_b, (LAS unsigned*)(lds + 131072)};
        pg8::gemm_phase<epi::EpiConv, pg8::StaticOrder, true, true>(lds, g, S, E);
        __syncthreads(); }
        SEAM(9);
    }

    if (IN(10)) { for (int rep_ = 0; rep_ <= RPT(10); ++rep_) {
        pg8::Gemm g{ACT2, WDN, ML, DM, DFF}; pg8::StaticOrder S; S.init(ML, DM, G_, bid);
        epi::EpiRes E{out, out, MOD + 5 * DM};
        pg8::gemm_phase<epi::EpiRes, pg8::StaticOrder, false, true>(lds, g, S, E);
    } }
#undef IN
#undef SEAM
}

#ifndef MK_SPLIT
#define MK_SPLIT 0
#endif
constexpr int NPHASE = 11;
#ifndef MK_RPTH
#define MK_RPTH 0
#endif
extern "C" void kernel_launch(void* const* d_in, const int* in_sizes, int n_in, void* d_out, int out_size, void* d_ws, size_t ws_size, hipStream_t stream) {
    static int grid = 0;
    if (grid == 0) {
        if (n_in != 30 || out_size != ML * DM || ws_size < WS_END) { fprintf(stderr, "kernel_launch: unexpected problem (n_in %d out %d ws %zu)\n", n_in, out_size, ws_size); grid = -1; return; }
        int dev = 0, cus = 0, per_cu = 0;
        hipGetDevice(&dev); hipDeviceGetAttribute(&cus, hipDeviceAttributeMultiprocessorCount, dev);
        if (hipFuncSetAttribute((const void*)mega_fwd, hipFuncAttributeMaxDynamicSharedMemorySize, LDS_BYTES) != hipSuccess) { fprintf(stderr, "kernel_launch: hipFuncSetAttribute failed\n"); grid = -1; return; }
        if (hipOccupancyMaxActiveBlocksPerMultiprocessor(&per_cu, (const void*)mega_fwd, NT, LDS_BYTES) != hipSuccess || per_cu < 1) per_cu = 1;
        (void)hipGetLastError();
        grid = cus * per_cu;
    }
    if (grid < 0) return;
    Args a{};
    for (int i = 0; i < 30; ++i) a.in[i] = (const float*)d_in[i];
    a.out = (float*)d_out; a.ws = (unsigned char*)d_ws;
#if MK_SPLIT
    for (int p = 0; p < NPHASE; ++p) for (int q = 0; q <= ((MK_RPTH >> p) & 1); ++q) { a.ph_lo = p; a.ph_hi = p + 1; hipLaunchKernelGGL(mega_fwd, dim3(grid), dim3(NT), LDS_BYTES, stream, a); }
#else
    a.ph_lo = 0; a.ph_hi = NPHASE;
    void* kargs[] = {&a};
    hipError_t e = hipLaunchCooperativeKernel((const void*)mega_fwd, dim3(grid), dim3(NT), kargs, LDS_BYTES, stream);
    if (e != hipSuccess) fprintf(stderr, "cooperative launch failed: %s (grid %d)\n", hipGetErrorString(e), grid);
#endif
}
```

```cpp
#include <hip/hip_runtime.h>
#include <hip/hip_cooperative_groups.h>
#include <cstdio>
#include <cstdint>
namespace cg = cooperative_groups;
namespace pg8 {
#define PG8_LAS __attribute__((address_space(3)))
typedef unsigned short bf16_t;
typedef short bf16x8 __attribute__((ext_vector_type(8)));
typedef float f32x4 __attribute__((ext_vector_type(4)));
typedef unsigned u32x4 __attribute__((ext_vector_type(4)));
constexpr int BM = 256, BK = 64, HALF = 128, HTB = HALF * BK * 2  , STAGE_BYTES = 8 * HTB, NXCD = 8, WGM = 8;

__host__ __device__ __forceinline__ int lds_byte(int r, int c) { const int st = (r >> 4) * 2 + (c >> 5), rr = r & 15, cc = c & 31, ob = rr * 64 + cc * 2; return st * 1024 + (ob ^ (((ob >> 9) & 1) << 5)); }
__host__ __device__ __forceinline__ void stage_rc(int b, int& R, int& C) { const int st = b / 1024, sb = b % 1024, swz = sb ^ (((sb >> 9) & 1) << 5); R = (st >> 1) * 16 + swz / 64; C = (st & 1) * 32 + (swz % 64) / 2; }
__host__ __device__ __forceinline__ int perm32(int rho) { const int n = rho >> 4, i = rho & 15; return 8 * (i >> 2) + 4 * n + (i & 3); }

struct Unit { int pm, pn; };
struct Gemm { const bf16_t* A; const bf16_t* Bt; int M, N, K; };

struct StaticOrder {
    int nM, nN, nwg, G, c, conv;
    __host__ __device__ void init(int M, int N, int G_, int c_) { nM = M / BM; nN = N / BM; nwg = nM * nN; G = G_; c = c_; conv = 0; }
    __host__ __device__ long arow(int pm) const { return conv ? (long)(pm / 17) * 4096 + 254 * (pm % 17) - 1 : (long)pm * BM; }
    __host__ __device__ bool next(int i, Unit& u) const {
        const long L = (long)i * G + c; if (L >= nwg) return false;
        int wgid = (int)L; { const int q = nwg / NXCD, r = nwg % NXCD, xcd = wgid % NXCD, off = wgid / NXCD; wgid = (xcd < r ? xcd * (q + 1) : r * (q + 1) + (xcd - r) * q) + off; }
        const int nig = WGM * nN, gid = wgid / nig, fm = gid * WGM, gsz = (nM - fm) < WGM ? (nM - fm) : WGM;
        u.pm = fm + ((wgid % nig) % gsz); u.pn = (wgid % nig) / gsz; return true;
    }
    __device__ __forceinline__ void a_ready(const Unit&) const {}
    __device__ __forceinline__ void done(const Unit&) const {}
};

typedef float f32x2c_t __attribute__((ext_vector_type(2))); typedef __bf16 bf16x2c_t __attribute__((ext_vector_type(2)));
__device__ __forceinline__ unsigned cvt_pk_bf16(float lo, float hi) { f32x2c_t v = {lo, hi}; bf16x2c_t b = __builtin_convertvector(v, bf16x2c_t); return __builtin_bit_cast(unsigned, b); }

template <class Epi, class Sched, bool ALIGN_EPI = false, bool SP2 = false>
__device__ __forceinline__ void gemm_phase(PG8_LAS unsigned char* lds, const Gemm g, const Sched& S, const Epi& E) {
    const int tid = threadIdx.x, wid = __builtin_amdgcn_readfirstlane(tid >> 6), lane = tid & 63, wr = wid >> 2, wc = wid & 3, fr = lane & 15, fq = lane >> 4;
    const int K = g.K, nt = K / BK;
    unsigned voffA[2], voffB[2];
#pragma unroll
    for (int i = 0; i < 2; ++i) { int R, C; stage_rc(tid * 16 + i * 8192, R, C); const int Rb = Epi::PERM ? ((R & ~31) + perm32(R & 31)) : R;
        voffA[i] = (unsigned)(R * K + C) * 2u; voffB[i] = (unsigned)(Rb * K + C) * 2u; }
    const size_t kstep = (size_t)(BK * 2);
    const size_t hstep = (size_t)HALF * K * 2;
    const size_t tstep = 2 * hstep;
    const unsigned ldsw = (unsigned)wid * 1024u;
    const int aoff = lds_byte(wr * 64 + fr, fq * 8), boff = lds_byte(wc * 32 + fr, fq * 8);
#define PG8_SA(b, h) (((b) * 2 + (h)) * HTB)
#define PG8_SB(b, h) ((4 + (b) * 2 + (h)) * HTB)
#define PG8_STAGE(bufoff, gbase, voff) do { _Pragma("unroll") for (int _i = 0; _i < 2; ++_i) \
        __builtin_amdgcn_global_load_lds((const unsigned*)((const char*)(gbase) + (voff)[_i]), (PG8_LAS unsigned*)(lds + (bufoff) + ldsw + _i * 8192), 16, 0, 0); } while (0)
#define PG8_LDA(dst, b, h) do { _Pragma("unroll") for (int m = 0; m < 4; ++m) _Pragma("unroll") for (int k = 0; k < 2; ++k) dst[m][k] = *(const PG8_LAS bf16x8*)(lds + PG8_SA(b, h) + aoff + m * 2048 + k * 1024); } while (0)
#define PG8_LDB(dst, b, h) do { _Pragma("unroll") for (int n = 0; n < 2; ++n) _Pragma("unroll") for (int k = 0; k < 2; ++k) dst[n][k] = *(const PG8_LAS bf16x8*)(lds + PG8_SB(b, h) + boff + n * 2048 + k * 1024); } while (0)
#define PG8_MMA(ai, bj, At, Bt) do { __builtin_amdgcn_s_setprio(1); _Pragma("unroll") for (int m = 0; m < 4; ++m) _Pragma("unroll") for (int n = 0; n < 2; ++n) _Pragma("unroll") for (int k = 0; k < 2; ++k) \
        acc[ai][bj][m][n] = __builtin_amdgcn_mfma_f32_16x16x32_bf16(Bt[n][k], At[m][k], acc[ai][bj][m][n], 0, 0, 0); __builtin_amdgcn_s_setprio(0); } while (0)
#define PG8_WAIT_V(n) asm volatile("s_waitcnt vmcnt(" #n ")" ::: "memory")
#define PG8_WAIT_L(n) asm volatile("s_waitcnt lgkmcnt(" #n ")" ::: "memory")
#define PG8_BAR __builtin_amdgcn_s_barrier()
#define PG8_SCHED __builtin_amdgcn_sched_barrier(0)
    Unit cur, nxt; int ui = 0;
    if (!S.next(0, cur)) return;
    f32x4 acc[2][2][4][2];
#pragma unroll
    for (int a = 0; a < 2; ++a)
#pragma unroll
        for (int b = 0; b < 2; ++b)
#pragma unroll
            for (int m = 0; m < 4; ++m)
#pragma unroll
                for (int n = 0; n < 2; ++n) acc[a][b][m][n] = (f32x4){0.f, 0.f, 0.f, 0.f};
    bf16x8 At[4][2], B0[2][2], B1[2][2];
    const char* cA = (const char*)g.A + S.arow(cur.pm) * (long)K * 2; const char* cB = (const char*)g.Bt + (size_t)cur.pn * tstep;
    S.a_ready(cur);
    if constexpr (SP2) {
        PG8_STAGE(PG8_SB(0, 0), cB, voffB); PG8_STAGE(PG8_SB(0, 1), cB + hstep, voffB); PG8_STAGE(PG8_SA(0, 0), cA, voffA); PG8_STAGE(PG8_SA(0, 1), cA + hstep, voffA);
        if (wr == 1) PG8_BAR;
        PG8_WAIT_V(2); PG8_BAR;
        PG8_STAGE(PG8_SB(1, 0), cB + kstep, voffB); PG8_STAGE(PG8_SA(1, 0), cA + kstep, voffA); PG8_STAGE(PG8_SB(1, 1), cB + hstep + kstep, voffB);
        PG8_WAIT_V(6); PG8_BAR;
    } else {
        PG8_STAGE(PG8_SB(0, 0), cB, voffB); PG8_STAGE(PG8_SA(0, 0), cA, voffA); PG8_STAGE(PG8_SB(0, 1), cB + hstep, voffB); PG8_STAGE(PG8_SA(0, 1), cA + hstep, voffA);
        if (wr == 1) PG8_BAR;
        PG8_WAIT_V(4); PG8_BAR;
        PG8_STAGE(PG8_SB(1, 0), cB + kstep, voffB); PG8_STAGE(PG8_SA(1, 0), cA + kstep, voffA); PG8_STAGE(PG8_SB(1, 1), cB + hstep + kstep, voffB);
        PG8_WAIT_V(6); PG8_BAR;
    }
    for (;;) {
        const bool has_next = S.next(ui + 1, nxt);
        const char* nA = has_next ? (const char*)g.A + S.arow(nxt.pm) * (long)K * 2 : cA; const char* nB = has_next ? (const char*)g.Bt + (size_t)nxt.pn * tstep : cB;
        for (int t = 0; t < nt; t += 2) {
            if constexpr (Epi::MIDK > 0) { if (t == Epi::MIDK) E.mid(acc, cur, wr, wc, fr, fq); }
            const bool last = (t == nt - 2);
            const char* a1 = cA + (size_t)(t + 1) * kstep;
            const char* a2 = last ? nA : cA + (size_t)(t + 2) * kstep; const char* b2 = last ? nB : cB + (size_t)(t + 2) * kstep;
            const char* a3 = a2 + kstep; const char* b3 = b2 + kstep;
            if (last && has_next) S.a_ready(nxt);
            if constexpr (SP2) {
            PG8_LDB(B0, 0, 0); PG8_LDB(B1, 0, 1); PG8_SCHED; PG8_LDA(At, 0, 0); PG8_STAGE(PG8_SA(1, 1), a1 + hstep, voffA);
            PG8_WAIT_V(8); PG8_WAIT_L(0); PG8_BAR; PG8_MMA(0, 0, At, B0); PG8_MMA(0, 1, At, B1); PG8_BAR; PG8_SCHED;
            PG8_LDA(At, 0, 1); PG8_STAGE(PG8_SB(0, 0), b2, voffB); PG8_STAGE(PG8_SB(0, 1), b2 + hstep, voffB); PG8_STAGE(PG8_SA(0, 0), a2, voffA);
            PG8_WAIT_V(8); PG8_WAIT_L(0); PG8_BAR; PG8_MMA(1, 0, At, B0); PG8_MMA(1, 1, At, B1); PG8_BAR; PG8_SCHED;
            PG8_LDB(B0, 1, 0); PG8_LDB(B1, 1, 1); PG8_SCHED; PG8_LDA(At, 1, 0); PG8_STAGE(PG8_SA(0, 1), a2 + hstep, voffA);
            PG8_WAIT_V(8); PG8_WAIT_L(0); PG8_BAR; PG8_MMA(0, 0, At, B0); PG8_MMA(0, 1, At, B1); PG8_BAR; PG8_SCHED;
            PG8_LDA(At, 1, 1); PG8_STAGE(PG8_SB(1, 0), b3, voffB); PG8_STAGE(PG8_SB(1, 1), b3 + hstep, voffB); PG8_STAGE(PG8_SA(1, 0), a3, voffA);
            PG8_WAIT_V(8); PG8_WAIT_L(0); PG8_BAR; PG8_MMA(1, 0, At, B0); PG8_MMA(1, 1, At, B1); PG8_BAR; PG8_SCHED;
            } else {
            PG8_LDB(B0, 0, 0); PG8_SCHED; PG8_LDA(At, 0, 0); PG8_STAGE(PG8_SA(1, 1), a1 + hstep, voffA);
            PG8_WAIT_L(8); PG8_BAR; PG8_WAIT_L(0); PG8_MMA(0, 0, At, B0); PG8_BAR; PG8_SCHED;
            PG8_LDB(B1, 0, 1); PG8_STAGE(PG8_SB(0, 0), b2, voffB);
            PG8_BAR; PG8_WAIT_L(0); PG8_MMA(0, 1, At, B1); PG8_BAR;
            PG8_LDA(At, 0, 1); PG8_STAGE(PG8_SA(0, 0), a2, voffA);
            PG8_BAR; PG8_WAIT_L(0); PG8_MMA(1, 0, At, B0); PG8_BAR; PG8_SCHED;
            PG8_STAGE(PG8_SB(0, 1), b2 + hstep, voffB);
            PG8_WAIT_V(6); PG8_BAR; PG8_MMA(1, 1, At, B1); PG8_BAR;
            PG8_LDB(B0, 1, 0); PG8_SCHED; PG8_LDA(At, 1, 0); PG8_STAGE(PG8_SA(0, 1), a2 + hstep, voffA);
            PG8_WAIT_L(8); PG8_BAR; PG8_WAIT_L(0); PG8_MMA(0, 0, At, B0); PG8_BAR; PG8_SCHED;
            PG8_LDB(B1, 1, 1); PG8_STAGE(PG8_SB(1, 0), b3, voffB);
            PG8_BAR; PG8_WAIT_L(0); PG8_MMA(0, 1, At, B1); PG8_BAR;
            PG8_LDA(At, 1, 1); PG8_STAGE(PG8_SA(1, 0), a3, voffA);
            PG8_BAR; PG8_WAIT_L(0); PG8_MMA(1, 0, At, B0); PG8_BAR; PG8_SCHED;
            PG8_STAGE(PG8_SB(1, 1), b3 + hstep, voffB);
            PG8_WAIT_V(6); PG8_BAR; PG8_MMA(1, 1, At, B1); PG8_BAR;
            }
        }
        if constexpr (ALIGN_EPI) { if (wr == 0) PG8_BAR; }
        if constexpr (!Epi::AFTER_DRAIN) { E(acc, cur, wr, wc, fr, fq); S.done(cur); }
        if (!has_next) break;
#pragma unroll
        for (int a = 0; a < 2; ++a)
#pragma unroll
            for (int b = 0; b < 2; ++b)
#pragma unroll
                for (int m = 0; m < 4; ++m)
#pragma unroll
                    for (int n = 0; n < 2; ++n) acc[a][b][m][n] = (f32x4){0.f, 0.f, 0.f, 0.f};
        cur = nxt; cA = nA; cB = nB; ++ui;
        if constexpr (ALIGN_EPI) { if (wr == 1) PG8_BAR; }
    }
    PG8_WAIT_V(0);
    if constexpr (!ALIGN_EPI) { if (wr == 0) PG8_BAR; }
    PG8_BAR;
    if constexpr (Epi::AFTER_DRAIN) { E.fused(acc, cur, wr, wc, fr, fq, lds, wid, lane); S.done(cur); }
#undef PG8_SA
#undef PG8_SB
#undef PG8_STAGE
#undef PG8_LDA
#undef PG8_LDB
#undef PG8_MMA
#undef PG8_WAIT_V
#undef PG8_WAIT_L
#undef PG8_BAR
#undef PG8_SCHED
}
}

#define GAS __attribute__((address_space(1)))
#define LAS __attribute__((address_space(3)))
typedef unsigned short bf16;
typedef unsigned v4u __attribute__((ext_vector_type(4)));
typedef unsigned v2u __attribute__((ext_vector_type(2)));
typedef float f32x4 __attribute__((ext_vector_type(4)));
typedef float f32x16 __attribute__((ext_vector_type(16)));
typedef short bf16x8 __attribute__((ext_vector_type(8)));
typedef short s16x4 __attribute__((ext_vector_type(4)));
typedef short v4i16_t __attribute__((ext_vector_type(4)));
#define LDS_WAIT() asm volatile("s_waitcnt lgkmcnt(0)" ::: "memory")
#define MFMA16(a, b, c) __builtin_amdgcn_mfma_f32_16x16x32_bf16((a), (b), (c), 0, 0, 0)
#define MFMA32(a, b, c) __builtin_amdgcn_mfma_f32_32x32x16_bf16((a), (b), (c), 0, 0, 0)

typedef float f32x2_t __attribute__((ext_vector_type(2))); typedef __bf16 bf16x2_t __attribute__((ext_vector_type(2)));
__device__ __forceinline__ unsigned pk2(float lo, float hi) { f32x2_t v = {lo, hi}; bf16x2_t b = __builtin_convertvector(v, bf16x2_t); return __builtin_bit_cast(unsigned, b); }
__device__ __forceinline__ unsigned f2bf(float f) { return pk2(f, f) & 0xffffu; }
__device__ __forceinline__ float bf2f(unsigned short h) { return __builtin_bit_cast(float, (unsigned)h << 16); }
__device__ __forceinline__ float bflo(unsigned u) { return __builtin_bit_cast(float, u << 16); }
__device__ __forceinline__ float bfhi(unsigned u) { return __builtin_bit_cast(float, u & 0xffff0000u); }
__device__ __forceinline__ float wave_sum(float v) {
#pragma unroll
    for (int o = 1; o < 64; o <<= 1) v += __shfl_xor(v, o);
    return v;
}
__device__ __forceinline__ float sigmoidf_(float x) { return __builtin_amdgcn_rcpf(1.f + __expf(-x)); }
__device__ __forceinline__ float siluf_(float x) { return x * __builtin_amdgcn_rcpf(1.f + __expf(-x)); }
__device__ __forceinline__ float logsigf_(float z) { return fminf(z, 0.f) - __logf(1.f + __expf(-fabsf(z))); }
__device__ __forceinline__ int crow(int r, int hi) { return (r & 3) + 8 * (r >> 2) + 4 * hi; }

constexpr int DM = 2048, NB = 2, SEQ = 4096, CTXL = 256;
constexpr int ML = NB * SEQ, MC = NB * CTXL, MT = ML + MC;
constexpr int NCAT = 10496, NACT = 6144, DFF = 5632, NUP = 11264, DIN = 6176;
constexpr int NITEM1 = 2 * 8 * 2 * 68;
constexpr float EPS = 1e-6f;
constexpr float LAM_INIT = 0.2f;
constexpr int NW = 8, NT = 512;
constexpr int LDS_BYTES = 147456;

constexpr size_t MiB = 1u << 20;
constexpr size_t WS_LAM = 4096, WS_BAR = 8192, WS_TAB = 32768  , WS_MOD = 65536;
constexpr size_t WS_WPG = 277 * MiB, WS_WPD = 281 * MiB, WS_WO = 395 * MiB, WS_WDN = 1 * MiB;
constexpr size_t WS_H = 23 * MiB, WS_WCAT = 57 * MiB, WS_LR = 98 * MiB, WS_GDEC = 100 * MiB;
constexpr size_t WS_U = 23 * MiB, WS_T1 = 23 * MiB, WS_H2 = 23 * MiB, WS_WUP = 351 * MiB, WS_ACT2 = 111 * MiB;
constexpr size_t WS_ACT1 = 111 * MiB, WS_G = 213 * MiB, WS_U2 = 111 * MiB;
constexpr size_t WS_S = 287 * MiB, WS_MRG = 287 * MiB, WS_YA = 319 * MiB, WS_YB = 335 * MiB, WS_END = 403 * MiB;

struct Args { const float* in[30]; float* out; unsigned char* ws; int ph_lo, ph_hi; };

namespace epi {
using pg8::Unit; using pg8::f32x4; using pg8::u32x4; using pg8::cvt_pk_bf16; using pg8::BM; using pg8::HALF;
#define EPI_LOOP for (int ai = 0; ai < 2; ++ai) for (int m = 0; m < 4; ++m) for (int bj = 0; bj < 2; ++bj)

struct EpiP2 {
    static constexpr bool PERM = true, AFTER_DRAIN = false; static constexpr int MIDK = 0;
    bf16* ACT1; bf16* G; float* LR; const float* b_gate;
    __device__ __forceinline__ void operator()(const f32x4 (&acc)[2][2][4][2], const Unit& u, int wr, int wc, int fr, int fq) const {
        const int row0 = u.pm * BM + wr * 64 + fr, cin = wc * 32 + 8 * fq;
        if (u.pn < 24) {
            const float sc = (u.pn < 2) ? 0.125f : 1.0f;
#pragma unroll
            EPI_LOOP { const f32x4 v0 = acc[ai][bj][m][0] * sc, v1 = acc[ai][bj][m][1] * sc;
                u32x4 w; w.x = cvt_pk_bf16(v0[0], v0[1]); w.y = cvt_pk_bf16(v0[2], v0[3]); w.z = cvt_pk_bf16(v1[0], v1[1]); w.w = cvt_pk_bf16(v1[2], v1[3]);
                *(u32x4*)(ACT1 + (size_t)(row0 + ai * HALF + m * 16) * NACT + u.pn * BM + bj * HALF + cin) = w; }
        } else if (u.pn < 40) {
            if (u.pm < ML / BM) {
                const int c0 = (u.pn - 24) * BM + cin;
                f32x4 bgv[2][2];
#pragma unroll
                for (int bj = 0; bj < 2; ++bj) { bgv[bj][0] = *(const f32x4*)(b_gate + c0 + bj * HALF); bgv[bj][1] = *(const f32x4*)(b_gate + c0 + bj * HALF + 4); }
#pragma unroll
                EPI_LOOP { const int col = c0 + bj * HALF;
                    const f32x4 v0 = acc[ai][bj][m][0] + bgv[bj][0], v1 = acc[ai][bj][m][1] + bgv[bj][1];
                    u32x4 w; w.x = cvt_pk_bf16(sigmoidf_(v0[0]), sigmoidf_(v0[1])); w.y = cvt_pk_bf16(sigmoidf_(v0[2]), sigmoidf_(v0[3]));
                    w.z = cvt_pk_bf16(sigmoidf_(v1[0]), sigmoidf_(v1[1])); w.w = cvt_pk_bf16(sigmoidf_(v1[2]), sigmoidf_(v1[3]));
                    *(u32x4*)(G + (size_t)(row0 + ai * HALF + m * 16) * 4096 + col) = w; }
            }
        } else {
            if (wc == 0) {
#pragma unroll
                for (int ai = 0; ai < 2; ++ai)
#pragma unroll
                    for (int m = 0; m < 4; ++m) { float* p = LR + (size_t)(row0 + ai * HALF + m * 16) * 32 + 8 * fq;
                        *(f32x4*)p = acc[ai][0][m][0]; *(f32x4*)(p + 4) = acc[ai][0][m][1]; }
            }
        }
    }
};
struct EpiMrg2 {
    static constexpr bool PERM = true, AFTER_DRAIN = false; static constexpr int MIDK = 16;
    const bf16* G; bf16* MRG;
    __device__ __forceinline__ void mid(f32x4 (&acc)[2][2][4][2], const Unit& u, int wr, int wc, int fr, int fq) const {
        int row0 = u.pm * BM + wr * 64 + fr, c0 = u.pn * BM + wc * 32 + 8 * fq;
        asm volatile("" : "+v"(row0), "+v"(c0));
#pragma unroll
        for (int ai = 0; ai < 2; ++ai) {
            u32x4 ga[4][2], gb[4][2];
#pragma unroll
            for (int m = 0; m < 4; ++m)
#pragma unroll
                for (int bj = 0; bj < 2; ++bj) { const bf16* gp = G + (size_t)(row0 + ai * HALF + m * 16) * 4096 + c0 + bj * HALF; ga[m][bj] = *(const u32x4*)gp; gb[m][bj] = *(const u32x4*)(gp + 2048); }
#pragma unroll
            for (int m = 0; m < 4; ++m)
#pragma unroll
                for (int bj = 0; bj < 2; ++bj) { const u32x4 a = ga[m][bj], b = gb[m][bj];
                    f32x4 v0 = acc[ai][bj][m][0], v1 = acc[ai][bj][m][1];
#define RC_(x) __builtin_amdgcn_rcpf(x)
                    v0[0] *= bflo(a.x) * RC_(bflo(b.x)); v0[1] *= bfhi(a.x) * RC_(bfhi(b.x)); v0[2] *= bflo(a.y) * RC_(bflo(b.y)); v0[3] *= bfhi(a.y) * RC_(bfhi(b.y));
                    v1[0] *= bflo(a.z) * RC_(bflo(b.z)); v1[1] *= bfhi(a.z) * RC_(bfhi(b.z)); v1[2] *= bflo(a.w) * RC_(bflo(b.w)); v1[3] *= bfhi(a.w) * RC_(bfhi(b.w));
#undef RC_
                    acc[ai][bj][m][0] = v0; acc[ai][bj][m][1] = v1; }
            __builtin_amdgcn_sched_barrier(0);
        }
    }
    __device__ __forceinline__ void operator()(const f32x4 (&acc)[2][2][4][2], const Unit& u, int wr, int wc, int fr, int fq) const {
        const int row0 = u.pm * BM + wr * 64 + fr, c0 = u.pn * BM + wc * 32 + 8 * fq;
        u32x4 gv[2][4][2];
#pragma unroll
        EPI_LOOP gv[ai][m][bj] = *(const u32x4*)(G + (size_t)(row0 + ai * HALF + m * 16) * 4096 + 2048 + c0 + bj * HALF);
#pragma unroll
        EPI_LOOP { const int row = row0 + ai * HALF + m * 16, col = c0 + bj * HALF; const u32x4 g = gv[ai][m][bj];
            const f32x4 a0 = acc[ai][bj][m][0], a1 = acc[ai][bj][m][1];
            u32x4 w; w.x = cvt_pk_bf16(a0[0] * bflo(g.x), a0[1] * bfhi(g.x)); w.y = cvt_pk_bf16(a0[2] * bflo(g.y), a0[3] * bfhi(g.y));
            w.z = cvt_pk_bf16(a1[0] * bflo(g.z), a1[1] * bfhi(g.z)); w.w = cvt_pk_bf16(a1[2] * bflo(g.w), a1[3] * bfhi(g.w));
            *(u32x4*)(MRG + (size_t)row * DM + col) = w; }
    }
};
struct EpiRes {
    static constexpr bool PERM = true, AFTER_DRAIN = false; static constexpr int MIDK = 0;
    const float* base; float* out; const float* gate;
    __device__ __forceinline__ void operator()(const f32x4 (&acc)[2][2][4][2], const Unit& u, int wr, int wc, int fr, int fq) const {
        const int row0 = u.pm * BM + wr * 64 + fr, c0 = u.pn * BM + wc * 32 + 8 * fq;
        const float* gb = gate + (size_t)((u.pm * BM) / SEQ) * 12288 + c0;
        f32x4 gg[2][2];
#pragma unroll
        for (int bj = 0; bj < 2; ++bj) { gg[bj][0] = *(const f32x4*)(gb + bj * HALF); gg[bj][1] = *(const f32x4*)(gb + bj * HALF + 4); }
#pragma unroll
        for (int ai = 0; ai < 2; ++ai) {
            f32x4 xb[4][2][2];
#pragma unroll
            for (int m = 0; m < 4; ++m)
#pragma unroll
                for (int bj = 0; bj < 2; ++bj) { const float* bp = base + (size_t)(row0 + ai * HALF + m * 16) * DM + c0 + bj * HALF; xb[m][bj][0] = *(const f32x4*)bp; xb[m][bj][1] = *(const f32x4*)(bp + 4); }
#pragma unroll
            for (int m = 0; m < 4; ++m)
#pragma unroll
                for (int bj = 0; bj < 2; ++bj) { float* p = out + (size_t)(row0 + ai * HALF + m * 16) * DM + c0 + bj * HALF;
                    *(f32x4*)p = xb[m][bj][0] + gg[bj][0] * acc[ai][bj][m][0]; *(f32x4*)(p + 4) = xb[m][bj][1] + gg[bj][1] * acc[ai][bj][m][1]; }
        }
    }
};
struct EpiPlain {
    static constexpr bool PERM = true, AFTER_DRAIN = false; static constexpr int MIDK = 0;
    bf16* O; int ldc;
    __device__ __forceinline__ void operator()(const f32x4 (&acc)[2][2][4][2], const Unit& u, int wr, int wc, int fr, int fq) const {
        const int row0 = u.pm * BM + wr * 64 + fr, c0 = u.pn * BM + wc * 32 + 8 * fq;
#pragma unroll
        EPI_LOOP { const f32x4 v0 = acc[ai][bj][m][0], v1 = acc[ai][bj][m][1];
            u32x4 w; w.x = cvt_pk_bf16(v0[0], v0[1]); w.y = cvt_pk_bf16(v0[2], v0[3]); w.z = cvt_pk_bf16(v1[0], v1[1]); w.w = cvt_pk_bf16(v1[2], v1[3]);
            *(u32x4*)(O + (size_t)(row0 + ai * HALF + m * 16) * ldc + c0 + bj * HALF) = w; }
    }
};
struct EpiConv {
    static constexpr bool PERM = true, AFTER_DRAIN = false; static constexpr int MIDK = 0;
    bf16* ACT2; const float* conv_w; const float* conv_b; __attribute__((address_space(3))) unsigned* halo;
    __device__ __forceinline__ void operator()(const f32x4 (&acc)[2][2][4][2], const Unit& u, int wr, int wc, int fr, int fq) const {
        unsigned P[2][4][8];
#pragma unroll
        for (int ai = 0; ai < 2; ++ai)
#pragma unroll
            for (int m = 0; m < 4; ++m)
#pragma unroll
                for (int bj = 0; bj < 2; ++bj) { const f32x4 v0 = acc[ai][bj][m][0], v1 = acc[ai][bj][m][1];
                    P[ai][m][4 * bj + 0] = cvt_pk_bf16(v0[0], v0[1]); P[ai][m][4 * bj + 1] = cvt_pk_bf16(v0[2], v0[3]);
                    P[ai][m][4 * bj + 2] = cvt_pk_bf16(v1[0], v1[1]); P[ai][m][4 * bj + 3] = cvt_pk_bf16(v1[2], v1[3]); }
#pragma unroll
        for (int ai = 0; ai < 2; ++ai) { const int rb = 2 * ai + wr;
            if (fr == 0) { __attribute__((address_space(3))) unsigned* hp = halo + (((rb * 2 + 0) * 4 + wc) * 4 + fq) * 8;
#pragma unroll
                for (int e = 0; e < 8; ++e) hp[e] = P[ai][0][e]; }
            if (fr == 15) { __attribute__((address_space(3))) unsigned* hp = halo + (((rb * 2 + 1) * 4 + wc) * 4 + fq) * 8;
#pragma unroll
                for (int e = 0; e < 8; ++e) hp[e] = P[ai][3][e]; } }
        asm volatile("s_waitcnt lgkmcnt(0)" ::: "memory");
        __builtin_amdgcn_s_barrier();
        asm volatile("" ::: "memory");
        const int c8 = u.pn * 128 + wc * 32 + 8 * fq;
        float wg[3][8], wv[3][8], bg[8], bv[8];
#pragma unroll
        for (int j = 0; j < 3; ++j) { const float* cw = conv_w + (size_t)j * NUP + c8;
            const f32x4 a0 = *(const f32x4*)cw, a1 = *(const f32x4*)(cw + 4), b0 = *(const f32x4*)(cw + DFF), b1 = *(const f32x4*)(cw + DFF + 4);
            wg[j][0] = a0[0]; wg[j][1] = a0[1]; wg[j][2] = a0[2]; wg[j][3] = a0[3]; wg[j][4] = a1[0]; wg[j][5] = a1[1]; wg[j][6] = a1[2]; wg[j][7] = a1[3];
            wv[j][0] = b0[0]; wv[j][1] = b0[1]; wv[j][2] = b0[2]; wv[j][3] = b0[3]; wv[j][4] = b1[0]; wv[j][5] = b1[1]; wv[j][6] = b1[2]; wv[j][7] = b1[3]; }
        { const f32x4 a0 = *(const f32x4*)(conv_b + c8), a1 = *(const f32x4*)(conv_b + c8 + 4), b0 = *(const f32x4*)(conv_b + DFF + c8), b1 = *(const f32x4*)(conv_b + DFF + c8 + 4);
          bg[0] = a0[0]; bg[1] = a0[1]; bg[2] = a0[2]; bg[3] = a0[3]; bg[4] = a1[0]; bg[5] = a1[1]; bg[6] = a1[2]; bg[7] = a1[3];
          bv[0] = b0[0]; bv[1] = b0[1]; bv[2] = b0[2]; bv[3] = b0[3]; bv[4] = b1[0]; bv[5] = b1[1]; bv[6] = b1[2]; bv[7] = b1[3]; }
        const int kt = u.pm % 17, bb = u.pm / 17;
#pragma unroll
        for (int ai = 0; ai < 2; ++ai) { const int rb = 2 * ai + wr;
#pragma unroll
            for (int m = 0; m < 4; ++m) {
                const int i = 128 * ai + 64 * wr + 16 * m + fr, t = 254 * kt + i - 1;
                unsigned up[8], dn[8];
#pragma unroll
                for (int e = 0; e < 8; ++e) {
                    const unsigned su = (fr == 15) ? P[ai][m > 0 ? m - 1 : 0][e] : P[ai][m][e];
                    const unsigned sd = (fr == 0) ? P[ai][m < 3 ? m + 1 : 3][e] : P[ai][m][e];
                    up[e] = (unsigned)__builtin_amdgcn_update_dpp(0, (int)su, 0x121, 0xf, 0xf, false);
                    dn[e] = (unsigned)__builtin_amdgcn_update_dpp(0, (int)sd, 0x12F, 0xf, 0xf, false);
                }
                if (m == 0 && fr == 0 && rb > 0) { const __attribute__((address_space(3))) unsigned* hp = halo + ((((rb - 1) * 2 + 1) * 4 + wc) * 4 + fq) * 8;
#pragma unroll
                    for (int e = 0; e < 8; ++e) up[e] = hp[e]; }
                if (m == 3 && fr == 15 && rb < 3) { const __attribute__((address_space(3))) unsigned* hp = halo + ((((rb + 1) * 2 + 0) * 4 + wc) * 4 + fq) * 8;
#pragma unroll
                    for (int e = 0; e < 8; ++e) dn[e] = hp[e]; }
                if (t == 0) {
#pragma unroll
                    for (int e = 0; e < 8; ++e) up[e] = 0u; }
                if (t == SEQ - 1) {
#pragma unroll
                    for (int e = 0; e < 8; ++e) dn[e] = 0u; }
                float o[8];
#pragma unroll
                for (int e2 = 0; e2 < 4; ++e2) {
                    const float g0 = bg[2 * e2] + wg[0][2 * e2] * bflo(up[e2]) + wg[1][2 * e2] * bflo(P[ai][m][e2]) + wg[2][2 * e2] * bflo(dn[e2]);
                    const float g1 = bg[2 * e2 + 1] + wg[0][2 * e2 + 1] * bfhi(up[e2]) + wg[1][2 * e2 + 1] * bfhi(P[ai][m][e2]) + wg[2][2 * e2 + 1] * bfhi(dn[e2]);
                    const float v0 = bv[2 * e2] + wv[0][2 * e2] * bflo(up[4 + e2]) + wv[1][2 * e2] * bflo(P[ai][m][4 + e2]) + wv[2][2 * e2] * bflo(dn[4 + e2]);
                    const float v1 = bv[2 * e2 + 1] + wv[0][2 * e2 + 1] * bfhi(up[4 + e2]) + wv[1][2 * e2 + 1] * bfhi(P[ai][m][4 + e2]) + wv[2][2 * e2 + 1] * bfhi(dn[4 + e2]);
                    o[2 * e2] = siluf_(g0) * v0; o[2 * e2 + 1] = siluf_(g1) * v1;
                }
                if (i >= 1 && i <= 254 && t < SEQ) {
                    u32x4 w; w.x = cvt_pk_bf16(o[0], o[1]); w.y = cvt_pk_bf16(o[2], o[3]); w.z = cvt_pk_bf16(o[4], o[5]); w.w = cvt_pk_bf16(o[6], o[7]);
                    *(u32x4*)(ACT2 + (size_t)(bb * SEQ + t) * DFF + c8) = w; }
            } }
    }
};
}

__device__ __forceinline__ void tr_item(const float* W, int ld, int k0, int col0, bf16* WT, int K, int row0, LAS float* scr, int lane, int dko = 0) {
#pragma unroll 8
    for (int i = 0; i < 32; ++i) { const int kk = 2 * i + (lane >> 5); scr[kk * 33 + (lane & 31)] = W[(size_t)(k0 + kk) * ld + col0 + (lane & 31)]; }
    LDS_WAIT(); asm volatile("" ::: "memory");
    const int c = lane & 7;
#pragma unroll
    for (int j = 0; j < 4; ++j) { const int n = (lane >> 3) + 8 * j; const LAS float* s = scr + (8 * c) * 33 + n;
        v4u o; o.x = pk2(s[0 * 33], s[1 * 33]); o.y = pk2(s[2 * 33], s[3 * 33]); o.z = pk2(s[4 * 33], s[5 * 33]); o.w = pk2(s[6 * 33], s[7 * 33]);
        *(v4u*)(WT + (size_t)(row0 + n) * K + dko + k0 + 8 * c) = o; }
    LDS_WAIT(); asm volatile("" ::: "memory");
}
#define TRJOB2(SRC, LD, KSRC, COL0, DST, KPITCH, DKO, ROW0, NCOLS) { const int nb_ = (NCOLS) / 32, ni_ = ((KSRC) / 64) * nb_; \
    if (r < ni_) { const int kb_ = r / nb_, nn_ = r % nb_; tr_item((SRC), (LD), 64 * kb_, (COL0) + 32 * nn_, (DST), (KPITCH), (ROW0) + 32 * nn_, scr, lane, (DKO)); continue; } r -= ni_; }
#define TRJOB(SRC, LD, KK, COL0, DST, ROW0, NCOLS) { const int nb_ = (NCOLS) / 32, ni_ = ((KK) / 64) * nb_; \
    if (r < ni_) { const int kb_ = r / nb_, nn_ = r % nb_; tr_item((SRC), (LD), 64 * kb_, (COL0) + 32 * nn_, (DST), (KK), (ROW0) + 32 * nn_, scr, lane); continue; } r -= ni_; }

__device__ __forceinline__ void norm_mod_row2(const float* __restrict__ xa, const float* __restrict__ xb, bool hasb, const float* __restrict__ nw, const float* __restrict__ mva, const float* __restrict__ mvb, int shoff, bf16* __restrict__ oa, bf16* __restrict__ ob, int lane) {
    const f32x4* xra = (const f32x4*)xa + lane; const f32x4* xrb = (const f32x4*)(hasb ? xb : xa) + lane;
    f32x4 va[8], vb[8]; float sa = 0.f, sb = 0.f;
#pragma unroll
    for (int j = 0; j < 8; ++j) { va[j] = xra[64 * j]; vb[j] = xrb[64 * j]; }
#pragma unroll
    for (int j = 0; j < 8; ++j) { sa += (va[j].x * va[j].x + va[j].y * va[j].y) + (va[j].z * va[j].z + va[j].w * va[j].w); sb += (vb[j].x * vb[j].x + vb[j].y * vb[j].y) + (vb[j].z * vb[j].z + vb[j].w * vb[j].w); }
    const float ra = rsqrtf(wave_sum(sa) * (1.f / DM) + EPS), rb = rsqrtf(wave_sum(sb) * (1.f / DM) + EPS);
#pragma unroll
    for (int j = 0; j < 8; ++j) { const int idx = 4 * (lane + 64 * j);
        const f32x4 w = *(const f32x4*)(nw + idx);
        { const f32x4 sh = *(const f32x4*)(mva + shoff + idx), sc = *(const f32x4*)(mva + shoff + DM + idx);
          const f32x4 y = (va[j] * ra * w) * (sc + 1.0f) + sh; v2u o; o.x = pk2(y.x, y.y); o.y = pk2(y.z, y.w); *(v2u*)(oa + idx) = o; }
        if (hasb) { const f32x4 sh = *(const f32x4*)(mvb + shoff + idx), sc = *(const f32x4*)(mvb + shoff + DM + idx);
          const f32x4 y = (vb[j] * rb * w) * (sc + 1.0f) + sh; v2u o; o.x = pk2(y.x, y.y); o.y = pk2(y.z, y.w); *(v2u*)(ob + idx) = o; } }
}

#define XB_TMO      128
#define XB_XCNT(j)  (256  + 64 * (j))
#define XB_XSUB(j)  (1280 + 64 * (j))
#define XB_XGEN(j)  (2304 + 64 * (j))
#define XB_TOP      3328
#define XB_TOPGEN   3392
#define XCD_BAR_WORDS 3456
#define XB_SPIN_CAP (1u << 18)

__device__ __forceinline__ unsigned xb_ld(unsigned* p)              { return __hip_atomic_load(p, __ATOMIC_RELAXED, __HIP_MEMORY_SCOPE_AGENT); }
__device__ __forceinline__ unsigned xb_add(unsigned* p, unsigned v) { return __hip_atomic_fetch_add(p, v, __ATOMIC_RELAXED, __HIP_MEMORY_SCOPE_AGENT); }
__device__ __forceinline__ unsigned xb_xcc_id() { return (unsigned)__builtin_amdgcn_s_getreg((3 << 11) | 20) & 0xFu; }
#define XB_SPIN(cond, bar) do { unsigned _sp = 0; while (cond) { __builtin_amdgcn_s_sleep(1); \
    if ((++_sp & 255u) == 0u) { if (xb_ld(&(bar)[XB_TMO])) break; if (_sp > XB_SPIN_CAP) { atomicAdd(&(bar)[XB_TMO], 1u); break; } } } } while (0)

struct XcdBarrier {
    unsigned* bar; unsigned x;
    volatile LAS unsigned* st;
};

__device__ __forceinline__ XcdBarrier xcd_barrier_post(unsigned* bar, volatile LAS unsigned* st) {
    XcdBarrier b; b.bar = bar; b.x = xb_xcc_id(); b.st = st;
    if (threadIdx.x == 0) (void)xb_add(&bar[XB_XCNT(b.x)], 1u);
    return b;
}
__device__ __forceinline__ void xcd_barrier_complete(unsigned* bar, unsigned x, unsigned& nloc, unsigned& nx) {
    const unsigned G = gridDim.x * gridDim.y * gridDim.z;
    unsigned sum, cnt, mine, sp = 0u;
    for (;;) {
        sum = 0u; cnt = 0u; mine = 0u;
#pragma unroll
        for (unsigned j = 0; j < 16; ++j) { const unsigned c = xb_ld(&bar[XB_XCNT(j)]); sum += c; cnt += (c > 0u) ? 1u : 0u; mine = (j == x) ? c : mine; }
        if (sum == G) break;
        __builtin_amdgcn_s_sleep(1);
        if ((++sp & 255u) == 0u) { if (xb_ld(&bar[XB_TMO])) break; if (sp > XB_SPIN_CAP) { atomicAdd(&bar[XB_TMO], 1u); break; } }
    }
    nloc = mine > 0u ? mine : 1u; nx = cnt > 0u ? cnt : 1u;
}

__device__ __forceinline__ void xcd_barrier(const XcdBarrier& b) {
    asm volatile("s_waitcnt vmcnt(0)" ::: "memory");
    __syncthreads();
    if (threadIdx.x == 0) {
        unsigned* bar = b.bar;
        __builtin_amdgcn_s_waitcnt(0);
        unsigned nloc = b.st[0], nx = b.st[1];
        if (nloc == 0u) { xcd_barrier_complete(bar, b.x, nloc, nx); b.st[0] = nloc; b.st[1] = nx; }
        const unsigned old = xb_add(&bar[XB_XSUB(b.x)], 1u);
        const unsigned gen = old / nloc;
        if (old + 1u == (gen + 1u) * nloc) {
            __builtin_amdgcn_fence(__ATOMIC_RELEASE, "agent");
            asm volatile("s_waitcnt vmcnt(0)" ::: "memory");
            const unsigned og = xb_add(&bar[XB_TOP], 1u);
            const unsigned tg = og / nx;
            if (og + 1u == (tg + 1u) * nx) xb_add(&bar[XB_TOPGEN], 1u);
            else XB_SPIN(xb_ld(&bar[XB_TOPGEN]) == tg, bar);
            __builtin_amdgcn_fence(__ATOMIC_ACQUIRE, "agent");
            xb_add(&bar[XB_XGEN(b.x)], 1u);
            asm volatile("s_waitcnt vmcnt(0)" ::: "memory");
        } else {
            XB_SPIN(xb_ld(&bar[XB_XGEN(b.x)]) == gen, bar);
            __builtin_amdgcn_fence(__ATOMIC_ACQUIRE, "agent");
            asm volatile("s_waitcnt vmcnt(0)" ::: "memory");
        }
    }
    __syncthreads();
}

__global__ void __launch_bounds__(NT, 2) mega_fwd(Args args) {
    extern __shared__ __attribute__((aligned(16))) unsigned char lds_raw[];
    LAS unsigned char* lds = (LAS unsigned char*)lds_raw;
    cg::grid_group grid = cg::this_grid();
    const int tid = threadIdx.x, lane = tid & 63, wave = __builtin_amdgcn_readfirstlane(tid >> 6);
    const int G_ = gridDim.x, bid = blockIdx.x;
    const int gw = bid * NW + wave, NGW = G_ * NW;
    const int lo = args.ph_lo, hi = args.ph_hi;
    const bool multi = (hi - lo) > 1;
    unsigned char* ws = args.ws;
    volatile LAS unsigned* xst = (volatile LAS unsigned*)(lds + LDS_BYTES - 16);
    if (tid < 4) xst[tid] = 0u;
    __syncthreads();
    XcdBarrier xb; xb.bar = (unsigned*)(ws + WS_BAR); xb.x = 0; xb.st = xst;
    if (multi && bid == 0) { unsigned* bw = (unsigned*)(ws + WS_BAR); for (int i = tid; i < XCD_BAR_WORDS; i += NT) bw[i] = 0u; }
#ifndef MK_RPT
#define MK_RPT 0
#endif
#define RPT(k) ((MK_RPT >> (k)) & 1)
#define IN(k) (lo <= (k) && (k) < hi)
#define SEAM(k) do { if (multi && IN((k) + 1)) { if ((k) == 0) { grid.sync(); xb = xcd_barrier_post((unsigned*)(ws + WS_BAR), xst); } else xcd_barrier(xb); } } while (0)

    const float* x = args.in[0]; const float* cvec = args.in[1]; const float* ctx = args.in[2]; const float* c_ctx = args.in[3];
    const float* w_ada = args.in[4]; const float* b_ada = args.in[5]; const float* norm1_w = args.in[6]; const float* w_in = args.in[7];
    const float* w_a_up_f = args.in[8]; const float* b_a_f = args.in[9]; const float* w_a_up_b = args.in[10]; const float* b_a_b = args.in[11];
    const float* gla_onorm_w = args.in[12]; const float* qnorm_w = args.in[13]; const float* knorm_w = args.in[14];
    const float* diff_onorm_w = args.in[19]; const float* w_proj_gla = args.in[20]; const float* w_proj_diff = args.in[21];
    const float* w_gate = args.in[22]; const float* b_gate = args.in[23]; const float* w_out = args.in[24]; const float* norm2_w = args.in[25];
    const float* w_up = args.in[26]; const float* conv_w = args.in[27]; const float* conv_b = args.in[28]; const float* w_down = args.in[29];
    float* out = args.out;
    float* MOD = (float*)(ws + WS_MOD); float* LAMP = (float*)(ws + WS_LAM);
    bf16* WCAT = (bf16*)(ws + WS_WCAT); bf16* WPG = (bf16*)(ws + WS_WPG); bf16* WPD = (bf16*)(ws + WS_WPD); bf16* WO = (bf16*)(ws + WS_WO);
    bf16* WUP = (bf16*)(ws + WS_WUP); bf16* WDN = (bf16*)(ws + WS_WDN);
    bf16* H = (bf16*)(ws + WS_H); bf16* H2 = (bf16*)(ws + WS_H2); bf16* ACT1 = (bf16*)(ws + WS_ACT1); bf16* GB = (bf16*)(ws + WS_G);
    float* LR = (float*)(ws + WS_LR); float* GDEC = (float*)(ws + WS_GDEC); float* UB = (float*)(ws + WS_U); bf16* SB = (bf16*)(ws + WS_S);
    bf16* YA = (bf16*)(ws + WS_YA); bf16* YB = (bf16*)(ws + WS_YB); float* T1 = (float*)(ws + WS_T1); bf16* MRG = (bf16*)(ws + WS_MRG);
    bf16* U2 = (bf16*)(ws + WS_U2); bf16* ACT2 = (bf16*)(ws + WS_ACT2);

    if (IN(0)) { for (int rep_ = 0; rep_ <= RPT(0); ++rep_) {
        {
            LAS float* sc = (LAS float*)lds; LAS float* red = sc + 3 * DM;
            for (int i = tid; i < 3 * DM; i += NT) { const int v = i / DM, k = i % DM; const float s = v < 2 ? cvec[v * DM + k] : c_ctx[k]; sc[i] = siluf_(s); }
            __syncthreads();
            const int cl = tid % 12, rl = tid / 12;
            for (int cb = bid; cb < 256; cb += G_) {
                f32x4 a0 = {0.f, 0.f, 0.f, 0.f}, a1 = a0, a2 = a0;
                if (tid < 504) {
                    const float* wp = w_ada + 48 * cb + 4 * cl;
                    for (int k = rl; k < DM; k += 42) { const f32x4 w = *(const f32x4*)(wp + (size_t)k * 12288); a0 += w * sc[k]; a1 += w * sc[DM + k]; a2 += w * sc[2 * DM + k]; }
                    LAS float* rp = red + (rl * 12 + cl) * 12;
#pragma unroll
                    for (int e = 0; e < 4; ++e) { rp[e] = a0[e]; rp[4 + e] = a1[e]; rp[8 + e] = a2[e]; }
                }
                __syncthreads();
                if (tid < 144) { const int cl2 = tid / 12, ve = tid % 12, v = ve >> 2, e = ve & 3; float s = 0.f;
                    for (int r2 = 0; r2 < 42; ++r2) s += red[(r2 * 12 + cl2) * 12 + ve];
                    const int n = 48 * cb + 4 * cl2 + e; MOD[v * 12288 + n] = s + b_ada[n]; }
                __syncthreads();
            }
            if (bid == 1 % G_) { float* tabg = (float*)(ws + WS_TAB);
                for (int i = tid; i < 1024; i += NT) { const int pos_ = i >> 4, f = i & 15;
                    const float invf = exp2f(-(float)f * (13.287712379549449f / 16.f));
                    float sn, cs; sincosf((float)pos_ * invf, &sn, &cs); tabg[2 * i] = cs; tabg[2 * i + 1] = sn; } }
            if (bid == 0 && tid == 0) { float s1 = 0.f, s2 = 0.f;
                for (int i = 0; i < 64; ++i) { s1 += args.in[15][i] * args.in[16][i]; s2 += args.in[17][i] * args.in[18][i]; }
                LAMP[0] = expf(s1) - expf(s2) + LAM_INIT; }
        }
        {
            LAS float* scr = (LAS float*)(lds + wave * 16384);
            constexpr int NITEMS = 2 * 32 * 96 + 32 * 128 + 32 * 1 + 2 * 16 * 64 + 32 * 64;
            for (int it = gw; it < NITEMS; it += NGW) {
                int r = it;
                TRJOB(w_in, DIN, 2048, 0, WCAT, 0, 3072)
                TRJOB(w_in, DIN, 2048, 3104, WCAT, 3072, 3072)
                TRJOB(w_gate, 4096, 2048, 0, WCAT, 6144, 4096)
                TRJOB(w_in, DIN, 2048, 3072, WCAT, 10240, 32)
                TRJOB2(w_proj_gla, 2048, 1024, 0, WPG, 2048, 0, 0, 2048)
                TRJOB2(w_proj_diff, 2048, 1024, 0, WPG, 2048, 1024, 0, 2048)
                TRJOB(w_out, 2048, 2048, 0, WO, 0, 2048)
            }
            v4u* z = (v4u*)(WCAT + (size_t)10272 * 2048);
            for (int i = bid * NT + tid; i < 224 * 2048 / 8; i += G_ * NT) z[i] = (v4u){0u, 0u, 0u, 0u};
        }
        __syncthreads(); }
        SEAM(0);
    }

    if (IN(1)) { for (int rep_ = 0; rep_ <= RPT(1); ++rep_) {
        for (int r = gw; r < MT; r += 2 * NGW) {
            const int r2 = r + NGW; const bool hb = r2 < MT; const int rb = hb ? r2 : r;
            const float* sa = r < ML ? x + (size_t)r * DM : ctx + (size_t)(r - ML) * DM;
            const float* sb = rb < ML ? x + (size_t)rb * DM : ctx + (size_t)(rb - ML) * DM;
            norm_mod_row2(sa, sb, hb, norm1_w, MOD + (size_t)(r < ML ? r / SEQ : 2) * 12288, MOD + (size_t)(rb < ML ? rb / SEQ : 2) * 12288, 0, H + (size_t)r * DM, H + (size_t)rb * DM, lane);
        }
        __syncthreads(); }
        SEAM(1);
    }

    if (IN(2)) { for (int rep_ = 0; rep_ <= RPT(2); ++rep_) {
        pg8::Gemm g{H, WCAT, MT, NCAT, DM}; pg8::StaticOrder S; S.init(MT, NCAT, G_, bid);
        epi::EpiP2 E{ACT1, GB, LR, b_gate};
        pg8::gemm_phase<epi::EpiP2, pg8::StaticOrder, true, true>(lds, g, S, E);
        {
            const int nun = (MT / 256) * (NCAT / 256), rounds = (nun + G_ - 1) / G_, nlast = nun - (rounds - 1) * G_;
            int nidle = G_ - nlast, j = bid - nlast;
            if (nidle == 0) { nidle = G_; j = bid; }
            if (j >= 0) {
                LAS float* scr = (LAS float*)(lds + wave * 16384);
                for (int it = j * NW + wave; it < 32 * 352 + 88 * 64; it += nidle * NW) {
                    if (it < 32 * 352) { const int kb = it / 352, nb = it % 352, row0 = 32 * nb, T = row0 >> 8, rr = row0 & 255;
                        const int col0 = rr < 128 ? 128 * T + rr : DFF + 128 * T + (rr - 128);
                        tr_item(w_up, NUP, 64 * kb, col0, WUP, 2048, row0, scr, lane); }
                    else { const int r = it - 32 * 352, kb = r / 64, nb = r % 64; tr_item(w_down, 2048, 64 * kb, 32 * nb, WDN, DFF, 32 * nb, scr, lane); } }
            }
        }
        __syncthreads(); }
        SEAM(2);
    }

    if (IN(3)) { for (int rep_ = 0; rep_ <= RPT(3); ++rep_) {
        {
            const float* tab = (const float*)(ws + WS_TAB);
            const int nheavy = (NITEM1 > NGW && NITEM1 - NGW < NGW) ? NITEM1 - NGW : 0;
            const int rw = gw - nheavy, nrw = NGW - nheavy;
            const int l8 = lane & 7;
            const bool lower = ((l8 >> 1) & 1) == 0;
            if (rw >= 0) for (int wi0 = rw; wi0 < MT * 4; wi0 += 2 * nrw) {
                v4u raw[2]; bool ok[2]; bf16* ptr[2];
#pragma unroll
                for (int u = 0; u < 2; ++u) { const int wi = wi0 + u * nrw, r = wi >> 2, gi = 8 * (wi & 3) + (lane >> 3);
                    ok[u] = (wi < MT * 4) && !(r >= ML && gi < 16);
                    ptr[u] = ACT1 + (size_t)(ok[u] ? r : 0) * NACT + 3072 + 64 * gi + 8 * l8;
                    raw[u] = ok[u] ? *(const v4u*)ptr[u] : (v4u){0u, 0u, 0u, 0u}; }
#pragma unroll
                for (int u = 0; u < 2; ++u) {
                    if (!ok[u]) continue;
                    const int wi = wi0 + u * nrw, r = wi >> 2, gi = 8 * (wi & 3) + (lane >> 3);
                    const bool isq = gi < 16;
                    float y[8] = {bflo(raw[u].x), bfhi(raw[u].x), bflo(raw[u].y), bfhi(raw[u].y), bflo(raw[u].z), bfhi(raw[u].z), bflo(raw[u].w), bfhi(raw[u].w)};
                    float ss = 0.f;
#pragma unroll
                    for (int e = 0; e < 8; ++e) ss += y[e] * y[e];
                    ss += __shfl_xor(ss, 1); ss += __shfl_xor(ss, 2); ss += __shfl_xor(ss, 4);
                    const float rs = rsqrtf(ss * (1.f / 64.f) + EPS);
                    const float* nwp = (isq ? qnorm_w : knorm_w) + 8 * l8;
#pragma unroll
                    for (int e = 0; e < 8; ++e) y[e] = y[e] * rs * nwp[e];
                    if (r < ML) {
                        const int t = r & (SEQ - 1); const int pos_ = (l8 < 4) ? (t >> 6) : (t & 63);
                        const float qs = isq ? 0.125f * 1.4426950408889634f : 1.0f;
                        const float* tp = tab + 2 * (pos_ * 16 + 8 * (l8 & 1));
#pragma unroll
                        for (int e = 0; e < 8; ++e) {
                            const float yp = __shfl_xor(y[e], 2);
                            const float cs = tp[2 * e], sn = tp[2 * e + 1];
                            y[e] = (lower ? (y[e] * cs - yp * sn) : (y[e] * cs + yp * sn)) * qs;
                        }
                    }
                    v4u o; o.x = pk2(y[0], y[1]); o.y = pk2(y[2], y[3]); o.z = pk2(y[4], y[5]); o.w = pk2(y[6], y[7]);
                    *(v4u*)ptr[u] = o;
                }
            }
        }
        {
            LAS unsigned char* wl = lds + wave * 18176;
            LAS float* tot = (LAS float*)(wl + 17920);
            const int l31 = lane & 31, hh = lane >> 5, qq = (lane & 15) >> 2, pp = lane & 3, blk = (lane >> 4) & 1;
            for (int item = gw; item < NITEM1; item += NGW) {
                const int c = item % 68, chain = item / 68, dir = chain & 1, bh = chain >> 1, h = bh & 7, b = bh >> 3;
                const int R0 = (c < 4) ? ML + 256 * b + (dir ? 192 - 64 * c : 64 * c) : SEQ * b + (dir ? SEQ - 64 * (c - 3) : 64 * (c - 4));
                const float* wup = (dir ? w_a_up_b : w_a_up_f) + 64 * h + lane;
                const float bias = (dir ? b_a_b : b_a_f)[64 * h + lane];
                int lri[16];
#pragma unroll
                for (int q4 = 0; q4 < 4; ++q4) { const f32x4 t_ = *(const f32x4*)(LR + (size_t)(R0 + lane) * 32 + 16 * dir + 4 * q4);
                    lri[4 * q4] = __float_as_int(t_.x); lri[4 * q4 + 1] = __float_as_int(t_.y); lri[4 * q4 + 2] = __float_as_int(t_.z); lri[4 * q4 + 3] = __float_as_int(t_.w); }
                float wu[16];
#pragma unroll
                for (int r2 = 0; r2 < 16; ++r2) wu[r2] = wup[r2 * 512];
                { const bf16* kp = ACT1 + (size_t)(R0 + lane) * NACT + 512 + 64 * h;
#pragma unroll
                  for (int c8 = 0; c8 < 8; ++c8) *(LAS v4u*)(wl + lane * 144 + 16 * c8) = *(const v4u*)(kp + 8 * c8); }
                LDS_WAIT(); asm volatile("" ::: "memory");
                float bsum = 0.f;
                for (int p = 0; p < 64; ++p) {
                    const int rho = dir ? 63 - p : p;
                    float z = bias;
#pragma unroll
                    for (int r2 = 0; r2 < 16; ++r2) z += __int_as_float(__builtin_amdgcn_readlane(lri[r2], rho)) * wu[r2];
                    bsum += logsigf_(z) * (1.f / 16.f);
                    LAS bf16* kq = (LAS bf16*)(wl + rho * 144) + lane;
                    *kq = (bf16)f2bf(bf2f(*kq) * __expf(-bsum));
                }
                const float et = __expf(bsum);
                tot[lane] = et; GDEC[(size_t)item * 64 + lane] = et;
#pragma unroll 1
                for (int eh = 0; eh < 2; ++eh) {
                    { const bf16* vp = ACT1 + (size_t)R0 * NACT + 1024 + 128 * h + 64 * eh;
#pragma unroll
                      for (int k2 = 0; k2 < 8; ++k2) { const int idx = lane + 64 * k2, row = idx >> 3, c8 = idx & 7;
                        const v4u t = *(const v4u*)(vp + (size_t)row * NACT + 8 * c8);
                        LAS unsigned char* dp = wl + 9216 + row * 136 + 16 * c8; *(LAS v2u*)dp = (v2u){t.x, t.y}; *(LAS v2u*)(dp + 8) = (v2u){t.z, t.w}; } }
                    LDS_WAIT(); asm volatile("" ::: "memory");
#pragma unroll
                    for (int db = 0; db < 2; ++db)
#pragma unroll
                        for (int eb = 0; eb < 2; ++eb) {
                            f32x16 acc;
#pragma unroll
                            for (int i = 0; i < 16; ++i) acc[i] = 0.f;
#pragma unroll
                            for (int s = 0; s < 4; ++s) {
                                const LAS unsigned char* ap = wl + (16 * s + 4 * hh + qq) * 144 + 64 * db + 32 * blk + 8 * pp;
                                const LAS unsigned char* bp = wl + 9216 + (16 * s + 4 * hh + qq) * 136 + 64 * eb + 32 * blk + 8 * pp;
                                const s16x4 alo = __builtin_bit_cast(s16x4, __builtin_amdgcn_ds_read_tr16_b64_v4i16((LAS v4i16_t*)ap));
                                const s16x4 ahi = __builtin_bit_cast(s16x4, __builtin_amdgcn_ds_read_tr16_b64_v4i16((LAS v4i16_t*)(ap + 8 * 144)));
                                const s16x4 blo = __builtin_bit_cast(s16x4, __builtin_amdgcn_ds_read_tr16_b64_v4i16((LAS v4i16_t*)bp));
                                const s16x4 bhi = __builtin_bit_cast(s16x4, __builtin_amdgcn_ds_read_tr16_b64_v4i16((LAS v4i16_t*)(bp + 8 * 136)));
                                acc = MFMA32(__builtin_shufflevector(alo, ahi, 0, 1, 2, 3, 4, 5, 6, 7), __builtin_shufflevector(blo, bhi, 0, 1, 2, 3, 4, 5, 6, 7), acc);
                            }
                            float* up = UB + (size_t)item * 8192 + (size_t)(64 * eh + 32 * eb + l31) * 64 + 32 * db + 4 * hh;
#pragma unroll
                            for (int g4 = 0; g4 < 4; ++g4) { const f32x4 t = *(const LAS f32x4*)(tot + 32 * db + 8 * g4 + 4 * hh);
                                *(f32x4*)(up + 8 * g4) = (f32x4){acc[4 * g4] * t.x, acc[4 * g4 + 1] * t.y, acc[4 * g4 + 2] * t.z, acc[4 * g4 + 3] * t.w}; }
                        }
                    LDS_WAIT(); asm volatile("" ::: "memory");
                }
            }
        }
        __syncthreads(); }
        SEAM(3);
    }

    if (IN(4)) { for (int rep_ = 0; rep_ <= RPT(4); ++rep_) {
        {
            typedef float f32x2_ __attribute__((ext_vector_type(2)));
            for (int ti = bid * NT + tid; ti < 131072; ti += G_ * NT) {
                const int chain = ti >> 12, el = ti & 4095, e = el >> 5, d2 = (el & 31) * 2;
                f32x2_ sv = {0.f, 0.f};
                const float* up = UB + (size_t)chain * 68 * 8192 + e * 64 + d2; const float* gp = GDEC + (size_t)chain * 68 * 64 + d2;
                bf16* sp = SB + (size_t)chain * 64 * 8192 + e * 64 + d2;
#pragma unroll 1
                for (int c0 = 0; c0 < 68; c0 += 17) {
                    f32x2_ uu[17], gg[17];
#pragma unroll
                    for (int j = 0; j < 17; ++j) { uu[j] = *(const f32x2_*)(up + (size_t)(c0 + j) * 8192); gg[j] = *(const f32x2_*)(gp + (c0 + j) * 64); }
#pragma unroll
                    for (int j = 0; j < 17; ++j) { const int c = c0 + j;
                        if (c >= 4) *(unsigned*)(sp + (size_t)(c - 4) * 8192) = pk2(sv.x, sv.y);
                        sv = gg[j] * sv + uu[j]; }
                }
            }
        }
        {
            const float lam = LAMP[0];
            float kbound; { float wmx = fabsf(knorm_w[lane]);
#pragma unroll
                for (int o = 1; o < 64; o <<= 1) wmx = fmaxf(wmx, __shfl_xor(wmx, o));
                kbound = 8.f * wmx * 1.01f; }
            const int mp = wave >> 2, qw = wave & 3, l31 = lane & 31, hh = lane >> 5;
            const int qq = (lane & 15) >> 2, pp = lane & 3, blk = (lane >> 4) & 1;
            constexpr int KP = 272, VP = 320, STG = 64 * KP + 64 * VP;
            for (int un = bid; un < 512; un += G_) {
                const int b = un >> 8, h = (un >> 5) & 7, qb = un & 31;
                const int Rq = SEQ * b + 128 * qb + 32 * qw + l31;
                bf16x8 qf[4];
#pragma unroll
                for (int ks = 0; ks < 4; ++ks) qf[ks] = *(const bf16x8*)(ACT1 + (size_t)Rq * NACT + 3072 + 128 * h + 64 * mp + 16 * ks + 8 * hh);
                f32x16 O[4];
#pragma unroll
                for (int eb = 0; eb < 4; ++eb)
#pragma unroll
                    for (int i = 0; i < 16; ++i) O[eb][i] = 0.f;
                float negm; float lsum = 0.f;
                { float qn2 = 0.f;
#pragma unroll
                  for (int ks = 0; ks < 4; ++ks)
#pragma unroll
                      for (int j = 0; j < 8; ++j) { const float qv = bf2f((unsigned short)qf[ks][j]); qn2 += qv * qv; }
                  qn2 += __shfl_xor(qn2, 32);
                  negm = -sqrtf(qn2) * kbound; }
                const int srow0 = tid >> 4, sc16 = tid & 15;
                v4u stK[2], stV[2];
#define ATT_LOAD(kt) do { const int krow0_ = (kt) < 4 ? ML + 256 * b + 64 * (kt) : SEQ * b + 64 * ((kt) - 4); \
                    _Pragma("unroll") for (int p = 0; p < 2; ++p) { const bf16* src_ = ACT1 + (size_t)(krow0_ + srow0 + 32 * p) * NACT + 128 * h + 8 * sc16; \
                        stK[p] = *(const v4u*)(src_ + 4096); stV[p] = *(const v4u*)(src_ + 5120); } } while (0)
#define ATT_STORE(stg) do { _Pragma("unroll") for (int p = 0; p < 2; ++p) { LAS unsigned char* d_ = lds + (stg) * STG + (srow0 + 32 * p) * KP + 16 * sc16; \
                        *(LAS v4u*)d_ = stK[p]; *(LAS v4u*)(lds + (stg) * STG + 64 * KP + (srow0 + 32 * p) * VP + 16 * sc16) = stV[p]; } } while (0)
                ATT_LOAD(0); ATT_STORE(0);
                __syncthreads();
                for (int kt = 0; kt < 68; ++kt) {
                    if (kt + 1 < 68) ATT_LOAD(kt + 1);
                    const LAS unsigned char* Kb = lds + (kt & 1) * STG; const LAS unsigned char* Vb = Kb + 64 * KP;
                    f32x16 X[2];
#pragma unroll
                    for (int t2 = 0; t2 < 2; ++t2) {
#pragma unroll
                        for (int i = 0; i < 16; ++i) X[t2][i] = 0.f;
#pragma unroll
                        for (int ks = 0; ks < 4; ++ks) { const bf16x8 kf = *(const LAS bf16x8*)(Kb + (32 * t2 + l31) * KP + 2 * (64 * mp + 16 * ks + 8 * hh)); X[t2] = MFMA32(kf, qf[ks], X[t2]); }
                    }
                    float ps = 0.f;
#pragma unroll
                    for (int t2 = 0; t2 < 2; ++t2)
#pragma unroll
                        for (int i = 0; i < 16; ++i) { const float p = __builtin_amdgcn_exp2f(X[t2][i] + negm); X[t2][i] = p; ps += p; }
                    lsum += ps;
#pragma unroll
                    for (int t2 = 0; t2 < 2; ++t2)
#pragma unroll
                        for (int s = 0; s < 2; ++s) {
                            v4u pk; pk.x = pk2(X[t2][8 * s + 0], X[t2][8 * s + 1]); pk.y = pk2(X[t2][8 * s + 2], X[t2][8 * s + 3]);
                            pk.z = pk2(X[t2][8 * s + 4], X[t2][8 * s + 5]); pk.w = pk2(X[t2][8 * s + 6], X[t2][8 * s + 7]);
                            const bf16x8 pf = __builtin_bit_cast(bf16x8, pk);
                            const LAS unsigned char* vrow = Vb + (32 * t2 + 16 * s + 4 * hh + qq) * VP + 32 * blk + 8 * pp;
#pragma unroll
                            for (int eb = 0; eb < 4; ++eb) {
                                const s16x4 vlo = __builtin_bit_cast(s16x4, __builtin_amdgcn_ds_read_tr16_b64_v4i16((LAS v4i16_t*)(vrow + 64 * eb)));
                                const s16x4 vhi = __builtin_bit_cast(s16x4, __builtin_amdgcn_ds_read_tr16_b64_v4i16((LAS v4i16_t*)(vrow + 8 * VP + 64 * eb)));
                                const bf16x8 vf = __builtin_shufflevector(vlo, vhi, 0, 1, 2, 3, 4, 5, 6, 7);
                                O[eb] = MFMA32(vf, pf, O[eb]);
                            }
                        }
                    if (kt + 1 < 68) ATT_STORE((kt + 1) & 1);
                    __syncthreads();
                }
#undef ATT_LOAD
#undef ATT_STORE
                lsum += __shfl_xor(lsum, 32);
                const float inv = 1.f / lsum;
                LAS float* ob = (LAS float*)lds;
                if (mp == 1) {
                    const float sc = inv * lam;
#pragma unroll
                    for (int eb = 0; eb < 4; ++eb)
#pragma unroll
                        for (int i = 0; i < 16; ++i) ob[(32 * qw + l31) * 132 + 32 * eb + crow(i, hh)] = O[eb][i] * sc;
                }
                __syncthreads();
                if (mp == 0) {
                    float ss = 0.f;
#pragma unroll
                    for (int eb = 0; eb < 4; ++eb)
#pragma unroll
                        for (int i = 0; i < 16; ++i) { const float v = O[eb][i] * inv - ob[(32 * qw + l31) * 132 + 32 * eb + crow(i, hh)]; O[eb][i] = v; ss += v * v; }
                    ss += __shfl_xor(ss, 32);
                    const float rs = rsqrtf(ss * (1.f / 128.f) + EPS) * (1.f - LAM_INIT);
                    bf16* yp = YA + (size_t)Rq * 2048 + 1024 + 128 * h;
                    f32x4 wn[4][4];
#pragma unroll
                    for (int eb = 0; eb < 4; ++eb)
#pragma unroll
                        for (int g4 = 0; g4 < 4; ++g4) wn[eb][g4] = *(const f32x4*)(diff_onorm_w + 32 * eb + 8 * g4 + 4 * hh);
#pragma unroll
                    for (int eb = 0; eb < 4; ++eb)
#pragma unroll
                        for (int g4 = 0; g4 < 4; ++g4) { const int e0 = 32 * eb + 8 * g4 + 4 * hh; const f32x4 w = wn[eb][g4];
                            v2u o; o.x = pk2(O[eb][4 * g4 + 0] * rs * w.x, O[eb][4 * g4 + 1] * rs * w.y); o.y = pk2(O[eb][4 * g4 + 2] * rs * w.z, O[eb][4 * g4 + 3] * rs * w.w);
                            *(v2u*)(yp + e0) = o; }
                }
                __syncthreads();
            }
        }
        __syncthreads(); }
        SEAM(4);
    }

    if (IN(5)) { for (int rep_ = 0; rep_ <= RPT(5); ++rep_) {
        const int g = tid >> 8, gwv = wave & 3, gt = tid & 255;
        LAS unsigned char* gl = lds + g * 55808;
        LAS float* xch = (LAS float*)(gl + 53248);
        const int l31 = lane & 31, hh = lane >> 5, qq = (lane & 15) >> 2, pp = lane & 3, blk = (lane >> 4) & 1;
        const int ib = gwv & 1, eh = gwv >> 1, itok = 32 * ib + l31;
        for (int pi = bid; pi < 512; pi += G_) {
            const int item = 2 * pi + g, m = item & 63, bh = item >> 6, h = bh & 7, b = bh >> 3, R0 = SEQ * b + 64 * m;
            bf16x8 Sfr[2][8]; v2u rr[2][4];
#pragma unroll
            for (int eb = 0; eb < 2; ++eb) {
#pragma unroll
                for (int ks = 0; ks < 8; ++ks) { const int dir = ks >> 2;
                    Sfr[eb][ks] = *(const bf16x8*)(SB + ((size_t)(bh * 2 + dir) * 64 + (dir ? 63 - m : m)) * 8192 + (size_t)(64 * eh + 32 * eb + l31) * 64 + 16 * (ks & 3) + 8 * hh); }
#pragma unroll
                for (int g4 = 0; g4 < 4; ++g4) rr[eb][g4] = *(const v2u*)(ACT1 + (size_t)(R0 + itok) * NACT + 2048 + 128 * h + 64 * eh + 32 * eb + 8 * g4 + 4 * hh);
            }
            {
                const int rw0 = 16 * gwv;
                float wuf[16], wub[16];
#pragma unroll
                for (int r2 = 0; r2 < 16; ++r2) { wuf[r2] = w_a_up_f[r2 * 512 + 64 * h + lane]; wub[r2] = w_a_up_b[r2 * 512 + 64 * h + lane]; }
                const float biasf = b_a_f[64 * h + lane], biasb = b_a_b[64 * h + lane];
                int lri[32];
#pragma unroll
                for (int q4 = 0; q4 < 8; ++q4) { const f32x4 t_ = *(const f32x4*)(LR + (size_t)(R0 + rw0 + (lane & 15)) * 32 + 4 * q4);
                    lri[4 * q4] = __float_as_int(t_.x); lri[4 * q4 + 1] = __float_as_int(t_.y); lri[4 * q4 + 2] = __float_as_int(t_.z); lri[4 * q4 + 3] = __float_as_int(t_.w); }
                unsigned short qraw[16], kraw[16];
                { const bf16* qp = ACT1 + (size_t)(R0 + rw0) * NACT + 64 * h + lane;
#pragma unroll
                  for (int i = 0; i < 16; ++i) { qraw[i] = qp[(size_t)i * NACT]; kraw[i] = qp[(size_t)i * NACT + 512]; } }
                { const bf16* vp = ACT1 + (size_t)(R0 + rw0) * NACT + 1024 + 128 * h;
#pragma unroll
                  for (int k2 = 0; k2 < 4; ++k2) { const int idx = lane + 64 * k2, row = idx >> 4, c16 = idx & 15;
                    *(LAS v4u*)(gl + 35840 + (rw0 + row) * 272 + 16 * c16) = *(const v4u*)(vp + (size_t)row * NACT + 8 * c16); } }
                float cf[16], cb[16];
#pragma unroll
                for (int i = 0; i < 16; ++i) { float zf = biasf, zb = biasb;
#pragma unroll
                    for (int r2 = 0; r2 < 16; ++r2) { zf += __int_as_float(__builtin_amdgcn_readlane(lri[r2], i)) * wuf[r2]; zb += __int_as_float(__builtin_amdgcn_readlane(lri[16 + r2], i)) * wub[r2]; }
                    cf[i] = logsigf_(zf) * (1.f / 16.f); cb[i] = logsigf_(zb) * (1.f / 16.f); }
#pragma unroll
                for (int i = 1; i < 16; ++i) cf[i] += cf[i - 1];
#pragma unroll
                for (int i = 14; i >= 0; --i) cb[i] += cb[i + 1];
                LAS float* segp = (LAS float*)(gl + 53248 + 512);
                segp[gwv * 64 + lane] = cf[15]; segp[256 + gwv * 64 + lane] = cb[0];
                __syncthreads();
                float offf = 0.f, offb = 0.f;
#pragma unroll
                for (int w2 = 0; w2 < 4; ++w2) { if (w2 < gwv) offf += segp[w2 * 64 + lane]; if (w2 > gwv) offb += segp[256 + w2 * 64 + lane]; }
#pragma unroll
                for (int i = 0; i < 16; ++i) { const int rho = rw0 + i;
                    const float ef = __expf(offf + cf[i]), eb_ = __expf(offb + cb[i]); const float qv = bf2f(qraw[i]), kv = bf2f(kraw[i]);
                    LAS bf16* qe = (LAS bf16*)(gl + rho * 272) + lane; LAS bf16* ke = (LAS bf16*)(gl + 17408 + rho * 144) + lane;
                    qe[0] = (bf16)f2bf(qv * ef); qe[64] = (bf16)f2bf(qv * eb_);
                    ke[0] = (bf16)f2bf(kv * __builtin_amdgcn_rcpf(ef)); ke[4608] = (bf16)f2bf(kv * __builtin_amdgcn_rcpf(eb_)); }
            }
            __syncthreads();
            bf16x8 qf[8];
#pragma unroll
            for (int ks = 0; ks < 8; ++ks) qf[ks] = *(const LAS bf16x8*)(gl + itok * 272 + 2 * (16 * ks + 8 * hh));
            bf16x8 pf[2][2];
#pragma unroll
            for (int jb = 0; jb < 2; ++jb) {
                f32x16 Xf, Xb;
#pragma unroll
                for (int i = 0; i < 16; ++i) { Xf[i] = 0.f; Xb[i] = 0.f; }
                if (jb <= ib) {
#pragma unroll
                    for (int ks = 0; ks < 4; ++ks) { const bf16x8 kf = *(const LAS bf16x8*)(gl + 17408 + (32 * jb + l31) * 144 + 2 * (16 * ks + 8 * hh)); Xf = MFMA32(kf, qf[ks], Xf); } }
                if (jb >= ib) {
#pragma unroll
                    for (int ks = 0; ks < 4; ++ks) { const bf16x8 kb = *(const LAS bf16x8*)(gl + 26624 + (32 * jb + l31) * 144 + 2 * (16 * ks + 8 * hh)); Xb = MFMA32(kb, qf[4 + ks], Xb); } }
                float pv[16];
#pragma unroll
                for (int r2 = 0; r2 < 16; ++r2) { const int j = 32 * jb + crow(r2, hh); pv[r2] = ((j <= itok) ? Xf[r2] : 0.f) + ((j >= itok) ? Xb[r2] : 0.f); }
#pragma unroll
                for (int s = 0; s < 2; ++s) { v4u pk; pk.x = pk2(pv[8 * s], pv[8 * s + 1]); pk.y = pk2(pv[8 * s + 2], pv[8 * s + 3]); pk.z = pk2(pv[8 * s + 4], pv[8 * s + 5]); pk.w = pk2(pv[8 * s + 6], pv[8 * s + 7]);
                    pf[jb][s] = __builtin_bit_cast(bf16x8, pk); }
            }
            f32x16 O[2]; float ss = 0.f;
#pragma unroll
            for (int eb = 0; eb < 2; ++eb) {
                f32x16 acc;
#pragma unroll
                for (int i = 0; i < 16; ++i) acc[i] = 0.f;
#pragma unroll
                for (int ks = 0; ks < 8; ++ks) acc = MFMA32(Sfr[eb][ks], qf[ks], acc);
#pragma unroll
                for (int jb = 0; jb < 2; ++jb)
#pragma unroll
                    for (int s = 0; s < 2; ++s) {
                        const LAS unsigned char* vp = gl + 35840 + (32 * jb + 16 * s + 4 * hh + qq) * 272 + 2 * (64 * eh + 32 * eb) + 32 * blk + 8 * pp;
                        const s16x4 vlo = __builtin_bit_cast(s16x4, __builtin_amdgcn_ds_read_tr16_b64_v4i16((LAS v4i16_t*)vp));
                        const s16x4 vhi = __builtin_bit_cast(s16x4, __builtin_amdgcn_ds_read_tr16_b64_v4i16((LAS v4i16_t*)(vp + 8 * 272)));
                        acc = MFMA32(__builtin_shufflevector(vlo, vhi, 0, 1, 2, 3, 4, 5, 6, 7), pf[jb][s], acc);
                    }
                O[eb] = acc;
#pragma unroll
                for (int i = 0; i < 16; ++i) ss += acc[i] * acc[i];
            }
            ss += __shfl_xor(ss, 32);
            if (hh == 0) xch[gwv * 32 + l31] = ss;
            __syncthreads();
            const float rs = rsqrtf((ss + xch[(gwv ^ 2) * 32 + l31]) * (1.f / 128.f) + EPS);
            bf16* yp = YA + (size_t)(R0 + itok) * 2048 + 128 * h + 64 * eh + 4 * hh;
            f32x4 wn[2][4];
#pragma unroll
            for (int eb = 0; eb < 2; ++eb)
#pragma unroll
                for (int g4 = 0; g4 < 4; ++g4) wn[eb][g4] = *(const f32x4*)(gla_onorm_w + 64 * eh + 32 * eb + 8 * g4 + 4 * hh);
#pragma unroll
            for (int eb = 0; eb < 2; ++eb)
#pragma unroll
                for (int g4 = 0; g4 < 4; ++g4) { const int e0 = 64 * eh + 32 * eb + 8 * g4 + 4 * hh; const f32x4 w = wn[eb][g4]; const v2u r_ = rr[eb][g4];
                    v2u o; o.x = pk2(O[eb][4 * g4] * rs * w.x * siluf_(bflo(r_.x)), O[eb][4 * g4 + 1] * rs * w.y * siluf_(bfhi(r_.x)));
                    o.y = pk2(O[eb][4 * g4 + 2] * rs * w.z * siluf_(bflo(r_.y)), O[eb][4 * g4 + 3] * rs * w.w * siluf_(bfhi(r_.y)));
                    *(v2u*)(yp + 32 * eb + 8 * g4) = o; }
        }
        __syncthreads(); }
        SEAM(5);
    }

    if (IN(6)) { for (int rep_ = 0; rep_ <= RPT(6); ++rep_) {
        pg8::Gemm g{YA, WPG, ML, DM, DM}; pg8::StaticOrder S; S.init(ML, DM, G_, bid);
        epi::EpiMrg2 E{GB, MRG};
        pg8::gemm_phase<epi::EpiMrg2, pg8::StaticOrder, false, true>(lds, g, S, E);
        __syncthreads(); }
        SEAM(6);
    }

    if (IN(7)) { for (int rep_ = 0; rep_ <= RPT(7); ++rep_) {
        pg8::Gemm g{MRG, WO, ML, DM, DM}; pg8::StaticOrder S; S.init(ML, DM, G_, bid);
        epi::EpiRes E{x, out, MOD + 2 * DM};
        pg8::gemm_phase<epi::EpiRes, pg8::StaticOrder, false, true>(lds, g, S, E);
        __syncthreads(); }
        SEAM(7);
    }

    if (IN(8)) { for (int rep_ = 0; rep_ <= RPT(8); ++rep_) {
        for (int r = gw; r < ML; r += 2 * NGW) {
            const int r2 = r + NGW; const bool hb = r2 < ML; const int rb = hb ? r2 : r;
            norm_mod_row2(out + (size_t)r * DM, out + (size_t)rb * DM, hb, norm2_w, MOD + (size_t)(r / SEQ) * 12288, MOD + (size_t)(rb / SEQ) * 12288, 3 * DM, H2 + (size_t)r * DM, H2 + (size_t)rb * DM, lane);
        }
        __syncthreads(); }
        SEAM(8);
    }

    if (IN(9)) { for (int rep_ = 0; rep_ <= RPT(9); ++rep_) {
        pg8::Gemm g{H2, WUP, 34 * 256, NUP, DM}; pg8::StaticOrder S; S.init(34 * 256, NUP, G_, bid); S.conv = 1;
        epi::EpiConv E{ACT2, conv_w, conv_b, (LAS unsigned*)(lds + 131072)};
        pg8::gemm_phase<epi::EpiConv, pg8::StaticOrder, true, true>(lds, g, S, E);
        __syncthreads(); }
        SEAM(9);
    }

    if (IN(10)) { for (int rep_ = 0; rep_ <= RPT(10); ++rep_) {
        pg8::Gemm g{ACT2, WDN, ML, DM, DFF}; pg8::StaticOrder S; S.init(ML, DM, G_, bid);
        epi::EpiRes E{out, out, MOD + 5 * DM};
        pg8::gemm_phase<epi::EpiRes, pg8::StaticOrder, false, true>(lds, g, S, E);
    } }
#undef IN
#undef SEAM
}

#ifndef MK_SPLIT
#define MK_SPLIT 0
#endif
constexpr int NPHASE = 11;
#ifndef MK_RPTH
#define MK_RPTH 0
#endif
extern "C" void kernel_launch(void* const* d_in, const int* in_sizes, int n_in, void* d_out, int out_size, void* d_ws, size_t ws_size, hipStream_t stream) {
    static int grid = 0;
    if (grid == 0) {
        if (n_in != 30 || out_size != ML * DM || ws_size < WS_END) { fprintf(stderr, "kernel_launch: unexpected problem (n_in %d out %d ws %zu)\n", n_in, out_size, ws_size); grid = -1; return; }
        int dev = 0, cus = 0, per_cu = 0;
        hipGetDevice(&dev); hipDeviceGetAttribute(&cus, hipDeviceAttributeMultiprocessorCount, dev);
        if (hipFuncSetAttribute((const void*)mega_fwd, hipFuncAttributeMaxDynamicSharedMemorySize, LDS_BYTES) != hipSuccess) { fprintf(stderr, "kernel_launch: hipFuncSetAttribute failed\n"); grid = -1; return; }
        if (hipOccupancyMaxActiveBlocksPerMultiprocessor(&per_cu, (const void*)mega_fwd, NT, LDS_BYTES) != hipSuccess || per_cu < 1) per_cu = 1;
        (void)hipGetLastError();
        grid = cus * per_cu;
    }
    if (grid < 0) return;
    Args a{};
    for (int i = 0; i < 30; ++i) a.in[i] = (const float*)d_in[i];
    a.out = (float*)d_out; a.ws = (unsigned char*)d_ws;
#if MK_SPLIT
    for (int p = 0; p < NPHASE; ++p) for (int q = 0; q <= ((MK_RPTH >> p) & 1); ++q) { a.ph_lo = p; a.ph_hi = p + 1; hipLaunchKernelGGL(mega_fwd, dim3(grid), dim3(NT), LDS_BYTES, stream, a); }
#else
    a.ph_lo = 0; a.ph_hi = NPHASE;
    void* kargs[] = {&a};
    hipError_t e = hipLaunchCooperativeKernel((const void*)mega_fwd, dim3(grid), dim3(NT), kargs, LDS_BYTES, stream);
    if (e != hipSuccess) fprintf(stderr, "cooperative launch failed: %s (grid %d)\n", hipGetErrorString(e), grid);
#endif
}
```
